# Optimizing an MI355X kernel written in HIP

```python
import math
import jax
import jax.numpy as jnp
from jax import lax
import numpy as np

D_MODEL = 1024
BATCH = 8
SEQ = 4096
DEPTH = 4

CTX_LEN = 256
GRID_W = 64
N_MIXERS = 3
N_MOD = 9
MACARON_WEIGHT = 0.5
D_FF = 256 * ((8 * D_MODEL // 3 + 255) // 256)
NORM_EPS = 1e-6
ROPE_THETA = 10000.0
Q_BLOCK = 128

DA_HEAD_DIM = 64
DA_HEADS = D_MODEL // (2 * DA_HEAD_DIM)
DA_WIDTH = DA_HEADS * 2 * DA_HEAD_DIM

HG_KEY = 128
HG_VAL = 128
HG_HEADS = D_MODEL // HG_VAL
HG_KW = HG_HEADS * HG_KEY
HG_VW = HG_HEADS * HG_VAL
HG_CHUNK = 64

GQA_HEAD_DIM = 128
GQA_Q_HEADS = D_MODEL // GQA_HEAD_DIM
GQA_KV_HEADS = GQA_Q_HEADS // 4
GQA_GROUP = GQA_Q_HEADS // GQA_KV_HEADS
GQA_Q_W = GQA_Q_HEADS * GQA_HEAD_DIM
GQA_KV_W = GQA_KV_HEADS * GQA_HEAD_DIM

N_DA = (DEPTH + N_MIXERS - 1) // N_MIXERS
N_HG = (DEPTH + N_MIXERS - 2) // N_MIXERS
N_GQA = (DEPTH + N_MIXERS - 3) // N_MIXERS

kernel_name = "hybrid_interleaved_dit_block"


def rmsnorm(x, g):
    xf = x.astype(jnp.float32)
    y = xf * lax.rsqrt(jnp.mean(xf * xf, axis=-1, keepdims=True) + NORM_EPS)
    return (y * g.astype(jnp.float32)).astype(x.dtype)


def modulate(x, g_pre, shift, scale):
    return rmsnorm(x, g_pre) * (1 + scale) + shift


def gated_residual(x, y, g_post, gate, weight):
    return x + weight * gate * rmsnorm(y, g_post)


def swiglu(h, w_in, w_out):
    gate, up = jnp.split(h @ w_in, 2, axis=-1)
    return (jax.nn.silu(gate) * up) @ w_out


def ffn_sublayer(x, shift, scale, gate, g_pre, g_post, w_in, w_out):
    y = swiglu(modulate(x, g_pre, shift, scale), w_in, w_out)
    return gated_residual(x, y, g_post, gate, MACARON_WEIGHT)


def axial_rope_tables(rows, head_dim):
    pairs = head_dim // 4
    inv_freq = jnp.power(ROPE_THETA, -jnp.arange(pairs, dtype=jnp.float32) / pairs)
    r = jnp.repeat(jnp.arange(rows, dtype=jnp.float32), GRID_W)
    col = jnp.tile(jnp.arange(GRID_W, dtype=jnp.float32), rows)
    ang = jnp.concatenate([r[:, None] * inv_freq, col[:, None] * inv_freq], axis=-1)
    return jnp.cos(ang), jnp.sin(ang)


def apply_rope(x, cos, sin):
    n, half = cos.shape
    shape = (1, n) + (1,) * (x.ndim - 3) + (half,)
    cs = cos.reshape(shape).astype(x.dtype)
    sn = sin.reshape(shape).astype(x.dtype)
    x1, x2 = x[..., 0::2], x[..., 1::2]
    return jnp.stack([x1 * cs - x2 * sn, x1 * sn + x2 * cs], axis=-1).reshape(x.shape)


def sweep_query_blocks(fn, q):
    bsz, n = q.shape[:2]
    qb = jnp.moveaxis(q.reshape((bsz, n // Q_BLOCK, Q_BLOCK) + q.shape[2:]), 1, 0)
    ob = lax.map(fn, qb)
    return jnp.moveaxis(ob, 0, 1).reshape((bsz, n) + ob.shape[3:])


def differential_attention(h_l, h_c, w_qkv, lam_p, subln, w_o, lam_init, cos, sin, need_ctx):
    bsz = h_l.shape[0]

    def project(h):
        n = h.shape[1]
        q, k, v = jnp.split(h @ w_qkv, 3, axis=-1)
        return (q.reshape(bsz, n, DA_HEADS, 2, DA_HEAD_DIM),
                k.reshape(bsz, n, DA_HEADS, 2, DA_HEAD_DIM),
                v.reshape(bsz, n, DA_HEADS, 2 * DA_HEAD_DIM))

    q_l, k_l, v_l = project(h_l)
    q_c, k_c, v_c = project(h_c)
    q_l = apply_rope(q_l, cos, sin)
    k_l = apply_rope(k_l, cos, sin)
    lp = lam_p.astype(jnp.float32)
    lam = jnp.exp(jnp.sum(lp[0] * lp[1])) - jnp.exp(jnp.sum(lp[2] * lp[3])) + lam_init
    scale = DA_HEAD_DIM ** -0.5

    def attend(q, k, v):
        s = jnp.einsum('bqhmd,bkhmd->bhmqk', q, k).astype(jnp.float32) * scale
        p = jax.nn.softmax(s, axis=-1)
        a = (p[:, :, 0] - lam * p[:, :, 1]).astype(v.dtype)
        return jnp.einsum('bhqk,bkhe->bqhe', a, v)

    def finish(o):
        o = rmsnorm(o, subln) * (1 - lam_init)
        return o.reshape(bsz, o.shape[1], DA_WIDTH) @ w_o

    k_all = jnp.concatenate([k_l, k_c], axis=1)
    v_all = jnp.concatenate([v_l, v_c], axis=1)
    y_l = finish(sweep_query_blocks(lambda qb: attend(qb, k_all, v_all), q_l))
    y_c = finish(attend(q_c, k_c, v_c)) if need_ctx else None
    return y_l, y_c


def gqa_attention(h_l, h_c, w_qkv, q_norm, k_norm, w_o, cos, sin, need_ctx):
    bsz = h_l.shape[0]

    def project(h):
        n = h.shape[1]
        q, k, v = jnp.split(h @ w_qkv, [GQA_Q_W, GQA_Q_W + GQA_KV_W], axis=-1)
        q = rmsnorm(q.reshape(bsz, n, GQA_KV_HEADS, GQA_GROUP, GQA_HEAD_DIM), q_norm)
        k = rmsnorm(k.reshape(bsz, n, GQA_KV_HEADS, GQA_HEAD_DIM), k_norm)
        return q, k, v.reshape(bsz, n, GQA_KV_HEADS, GQA_HEAD_DIM)

    q_l, k_l, v_l = project(h_l)
    q_c, k_c, v_c = project(h_c)
    q_l = apply_rope(q_l, cos, sin)
    k_l = apply_rope(k_l, cos, sin)
    scale = GQA_HEAD_DIM ** -0.5

    def attend(q, k, v):
        s = jnp.einsum('bqhgd,bkhd->bhgqk', q, k).astype(jnp.float32) * scale
        p = jax.nn.softmax(s, axis=-1).astype(v.dtype)
        return jnp.einsum('bhgqk,bkhd->bqhgd', p, v)

    def finish(o):
        return o.reshape(bsz, o.shape[1], GQA_Q_W) @ w_o

    k_all = jnp.concatenate([k_l, k_c], axis=1)
    v_all = jnp.concatenate([v_l, v_c], axis=1)
    y_l = finish(sweep_query_blocks(lambda qb: attend(qb, k_all, v_all), q_l))
    y_c = finish(attend(q_c, k_c, v_c)) if need_ctx else None
    return y_l, y_c


def chunkwise_gated_scan(q, k, v, log_f, s0):
    bsz, n, heads, _ = q.shape
    nc = n // HG_CHUNK

    def to_chunks(a):
        return jnp.moveaxis(a.reshape(bsz, nc, HG_CHUNK, heads, a.shape[-1]), 1, 0)

    lower_tri = jnp.tril(jnp.ones((HG_CHUNK, HG_CHUNK), dtype=bool))[None, :, :, None, None]

    def step(state, chunk):
        qc, kc, vc, gc = chunk
        G = jnp.cumsum(gc, axis=1)
        g_last = G[:, -1]
        o_inter = jnp.einsum('bthk,bhkv->bthv', qc * jnp.exp(G), state)
        rel = jnp.exp(jnp.where(lower_tri, G[:, :, None] - G[:, None, :], -jnp.inf))
        att = jnp.einsum('bthk,btshk,bshk->bhts', qc, rel, kc)
        o_intra = jnp.einsum('bhts,bshv->bthv', att, vc)
        state = (jnp.exp(g_last)[..., None] * state
                 + jnp.einsum('bshk,bshv->bhkv', kc * jnp.exp(g_last[:, None] - G), vc))
        return state, o_inter + o_intra

    s_fin, o = lax.scan(step, s0, (to_chunks(q), to_chunks(k), to_chunks(v), to_chunks(log_f)))
    return jnp.moveaxis(o, 0, 1).reshape(bsz, n, heads, v.shape[-1]), s_fin


def hgrn2_bidirectional(h_l, h_c, w_in, lb_fwd, lb_bwd, norm_g, w_o, need_ctx):
    bsz = h_l.shape[0]
    lbs = (lb_fwd.reshape(HG_HEADS, HG_KEY), lb_bwd.reshape(HG_HEADS, HG_KEY))

    def project(h):
        n = h.shape[1]
        q, f_fwd, f_bwd, i_in, gate = jnp.split(
            h @ w_in, [HG_KW, 2 * HG_KW, 3 * HG_KW, 3 * HG_KW + HG_VW], axis=-1)

        def heads(a, d):
            return a.reshape(bsz, n, HG_HEADS, d).astype(jnp.float32)

        q = jax.nn.silu(heads(q, HG_KEY))
        gates = []
        for f_logit, lb in zip((f_fwd, f_bwd), lbs):
            f = lb + (1 - lb) * jax.nn.sigmoid(heads(f_logit, HG_KEY))
            gates.append((1 - f, jnp.log(f)))
        return q, gates, heads(i_in, HG_VAL), gate

    q_l, gates_l, v_l, gate_l = project(h_l)
    q_c, gates_c, v_c, gate_c = project(h_c)
    (k_cf, lf_cf), (k_cb, lf_cb) = gates_c
    (k_lf, lf_lf), (k_lb, lf_lb) = gates_l

    def flip(a):
        return a[:, ::-1]

    s0 = jnp.zeros((bsz, HG_HEADS, HG_KEY, HG_VAL), jnp.float32)
    o_cf, s_cf = chunkwise_gated_scan(q_c, k_cf, v_c, lf_cf, s0)
    o_cb, s_cb = chunkwise_gated_scan(flip(q_c), flip(k_cb), flip(v_c), flip(lf_cb), s0)
    o_lf, _ = chunkwise_gated_scan(q_l, k_lf, v_l, lf_lf, s_cf)
    o_lb, _ = chunkwise_gated_scan(flip(q_l), flip(k_lb), flip(v_l), flip(lf_lb), s_cb)

    def finish(o, gate):
        n = o.shape[1]
        o = rmsnorm(o, norm_g).reshape(bsz, n, HG_VW).astype(gate.dtype) * jax.nn.silu(gate)
        return o @ w_o

    y_l = finish(o_lf + flip(o_lb), gate_l)
    y_c = finish(o_cf + flip(o_cb), gate_c) if need_ctx else None
    return y_l, y_c


def setup_inputs(seed: int = 0) -> dict:
    key = jax.random.key(seed)
    ks = jax.random.split(key, 24)

    def nrm(k, shape, scale):
        return scale * jax.random.normal(k, shape, jnp.float32)

    def gain(k, shape):
        return 1.0 + 0.02 * jax.random.normal(k, shape, jnp.float32)

    return {
        "x": nrm(ks[0], (BATCH, SEQ, D_MODEL), 1.0),
        "c": nrm(ks[1], (BATCH, D_MODEL), 1.0),
        "ctx": nrm(ks[2], (BATCH, CTX_LEN, D_MODEL), 1.0),
        "c_ctx": nrm(ks[3], (D_MODEL,), 1.0),
        "w_mod": nrm(ks[4], (DEPTH, D_MODEL, N_MOD * D_MODEL), 0.5 * D_MODEL ** -0.5),
        "b_mod": nrm(ks[5], (DEPTH, N_MOD * D_MODEL), 0.01),
        "norm_g": gain(ks[6], (DEPTH, 6, D_MODEL)),
        "ffn_w_in": nrm(ks[7], (DEPTH, 2, D_MODEL, 2 * D_FF), D_MODEL ** -0.5),
        "ffn_w_out": nrm(ks[8], (DEPTH, 2, D_FF, D_MODEL), D_FF ** -0.5),
        "da_w_qkv": nrm(ks[9], (N_DA, D_MODEL, 3 * DA_WIDTH), D_MODEL ** -0.5),
        "da_lambda": nrm(ks[10], (N_DA, 4, DA_HEAD_DIM), 0.1),
        "da_subln": gain(ks[11], (N_DA, 2 * DA_HEAD_DIM)),
        "da_w_o": nrm(ks[12], (N_DA, DA_WIDTH, D_MODEL), DA_WIDTH ** -0.5),
        "hg_w_in": nrm(ks[13], (N_HG, D_MODEL, 3 * HG_KW + 2 * HG_VW), D_MODEL ** -0.5),
        "hg_lower_bound": nrm(ks[14], (2, DEPTH, HG_KW), 0.5),
        "hg_norm": gain(ks[15], (N_HG, HG_VAL)),
        "hg_w_o": nrm(ks[16], (N_HG, HG_VW, D_MODEL), HG_VW ** -0.5),
        "gqa_w_qkv": nrm(ks[17], (N_GQA, D_MODEL, GQA_Q_W + 2 * GQA_KV_W), D_MODEL ** -0.5),
        "gqa_q_norm": gain(ks[18], (N_GQA, GQA_HEAD_DIM)),
        "gqa_k_norm": gain(ks[19], (N_GQA, GQA_HEAD_DIM)),
        "gqa_w_o": nrm(ks[20], (N_GQA, GQA_Q_W, D_MODEL), GQA_Q_W ** -0.5),
    }


def reference(x, c, ctx, c_ctx, w_mod, b_mod, norm_g, ffn_w_in, ffn_w_out,
              da_w_qkv, da_lambda, da_subln, da_w_o,
              hg_w_in, hg_lower_bound, hg_norm, hg_w_o,
              gqa_w_qkv, gqa_q_norm, gqa_k_norm, gqa_w_o):
    bsz, n_lat, _ = x.shape
    rows = n_lat // GRID_W
    da_cos, da_sin = axial_rope_tables(rows, DA_HEAD_DIM)
    gqa_cos, gqa_sin = axial_rope_tables(rows, GQA_HEAD_DIM)
    lb_table = jnp.cumsum(jax.nn.softmax(hg_lower_bound.astype(jnp.float32), axis=1), axis=1)
    lb_table = lb_table - lb_table[:, :1]
    silu_c = jax.nn.silu(c)
    silu_cc = jax.nn.silu(c_ctx)
    xl, xc = x, ctx
    for i in range(DEPTH):
        kind, j = i % N_MIXERS, i // N_MIXERS
        need_ctx = i < DEPTH - 1
        mod_l = (silu_c @ w_mod[i] + b_mod[i]).reshape(bsz, N_MOD, 1, D_MODEL)
        mod_c = (silu_cc @ w_mod[i] + b_mod[i]).reshape(N_MOD, D_MODEL)
        g = norm_g[i]
        xl = ffn_sublayer(xl, mod_l[:, 0], mod_l[:, 1], mod_l[:, 2], g[0], g[1],
                          ffn_w_in[i, 0], ffn_w_out[i, 0])
        xc = ffn_sublayer(xc, mod_c[0], mod_c[1], mod_c[2], g[0], g[1],
                          ffn_w_in[i, 0], ffn_w_out[i, 0])
        hl = modulate(xl, g[2], mod_l[:, 3], mod_l[:, 4])
        hc = modulate(xc, g[2], mod_c[3], mod_c[4])
        if kind == 0:
            lam_init = 0.8 - 0.6 * math.exp(-0.3 * i)
            yl, yc = differential_attention(hl, hc, da_w_qkv[j], da_lambda[j], da_subln[j],
                                            da_w_o[j], lam_init, da_cos, da_sin, need_ctx)
        elif kind == 1:
            yl, yc = hgrn2_bidirectional(hl, hc, hg_w_in[j], lb_table[0, i], lb_table[1, i],
                                         hg_norm[j], hg_w_o[j], need_ctx)
        else:
            yl, yc = gqa_attention(hl, hc, gqa_w_qkv[j], gqa_q_norm[j], gqa_k_norm[j],
                                   gqa_w_o[j], gqa_cos, gqa_sin, need_ctx)
        xl = gated_residual(xl, yl, g[3], mod_l[:, 5], 1.0)
        xl = ffn_sublayer(xl, mod_l[:, 6], mod_l[:, 7], mod_l[:, 8], g[4], g[5],
                          ffn_w_in[i, 1], ffn_w_out[i, 1])
        if need_ctx:
            xc = gated_residual(xc, yc, g[3], mod_c[5], 1.0)
            xc = ffn_sublayer(xc, mod_c[6], mod_c[7], mod_c[8], g[4], g[5],
                              ffn_w_in[i, 1], ffn_w_out[i, 1])
    return xl
```

```cpp
#include <hip/hip_runtime.h>
#include <hip/hip_cooperative_groups.h>
#include <cstdio>
#include <cstdint>
namespace cg = cooperative_groups;
__device__ __forceinline__ int my_tid(int wave_s) { unsigned m = ~0u; asm volatile("" : "+s"(m)); return (wave_s << 6) | (int)__builtin_amdgcn_mbcnt_hi(m, __builtin_amdgcn_mbcnt_lo(m, 0u)); }
namespace pg8 {
#define PG8_LAS __attribute__((address_space(3)))
typedef unsigned short bf16_t;
typedef short bf16x8 __attribute__((ext_vector_type(8)));
typedef float f32x4 __attribute__((ext_vector_type(4)));
typedef unsigned u32x4 __attribute__((ext_vector_type(4)));
constexpr int BM = 256, BK = 64, HALF = 128, HTB = HALF * BK * 2  , STAGE_BYTES = 8 * HTB, NXCD = 8, WGM = 8;

__host__ __device__ __forceinline__ int lds_byte(int r, int c) { const int st = (r >> 4) * 2 + (c >> 5), rr = r & 15, cc = c & 31, ob = rr * 64 + cc * 2; return st * 1024 + (ob ^ (((ob >> 9) & 1) << 5)); }
__host__ __device__ __forceinline__ void stage_rc(int b, int& R, int& C) { const int st = b / 1024, sb = b % 1024, swz = sb ^ (((sb >> 9) & 1) << 5); R = (st >> 1) * 16 + swz / 64; C = (st & 1) * 32 + (swz % 64) / 2; }
__host__ __device__ __forceinline__ int perm32(int rho) { const int n = rho >> 4, i = rho & 15; return 8 * (i >> 2) + 4 * n + (i & 3); }

struct Unit { int pm, pn; };
struct Gemm { const bf16_t* A; const bf16_t* Bt; int M, N, K; int ld = 0; };

struct StaticOrder {
    int nM, nN, nwg, G, c;
    __host__ __device__ void init(int M, int N, int G_, int c_) { nM = M / BM; nN = N / BM; nwg = nM * nN; G = G_; c = c_; }
    __host__ __device__ bool next(int i, Unit& u) const {
        const long L = (long)i * G + c; if (L >= nwg) return false;
        int wgid = (int)L; { const int q = nwg / NXCD, r = nwg % NXCD, xcd = wgid % NXCD, off = wgid / NXCD; wgid = (xcd < r ? xcd * (q + 1) : r * (q + 1) + (xcd - r) * q) + off; }
        const int nig = WGM * nN, gid = wgid / nig, fm = gid * WGM, gsz = (nM - fm) < WGM ? (nM - fm) : WGM;
        u.pm = fm + ((wgid % nig) % gsz); u.pn = (wgid % nig) / gsz; return true;
    }
    __device__ __forceinline__ void a_ready(const Unit&) const {}
    __device__ __forceinline__ void done(const Unit&) const {}
};
__device__ __forceinline__ unsigned cvt_pk_bf16(float lo, float hi) { unsigned r; asm volatile("v_cvt_pk_bf16_f32 %0, %1, %2" : "=v"(r) : "v"(lo), "v"(hi)); return r; }
__device__ __forceinline__ float silu_f(float x) { return x * __builtin_amdgcn_rcpf(1.f + __builtin_amdgcn_exp2f(-1.4426950408889634f * x)); }
__device__ __forceinline__ float sigm_f(float x) { return __builtin_amdgcn_rcpf(1.f + __builtin_amdgcn_exp2f(-1.4426950408889634f * x)); }
constexpr int SS_LD = 40;

struct EpiSwiglu { static constexpr bool PERM = true, AFTER_DRAIN = false; bf16_t* O; int ldc;
    __device__ __forceinline__ void operator()(const f32x4 (&acc)[2][2][4][2], const Unit& u, int wr, int wc, int fr, int fq) const {
        const int row0 = u.pm * BM + wr * 64 + fr, col0 = u.pn * HALF + wc * 32 + 8 * fq;
#pragma unroll
        for (int ai = 0; ai < 2; ++ai)
#pragma unroll
            for (int m = 0; m < 4; ++m) { bf16_t* rowp = O + (size_t)(row0 + ai * HALF + m * 16) * ldc + col0;
                const f32x4 g0 = acc[ai][0][m][0], g1 = acc[ai][0][m][1], u0 = acc[ai][1][m][0], u1 = acc[ai][1][m][1];
                u32x4 w; w.x = cvt_pk_bf16(silu_f(g0[0]) * u0[0], silu_f(g0[1]) * u0[1]); w.y = cvt_pk_bf16(silu_f(g0[2]) * u0[2], silu_f(g0[3]) * u0[3]);
                w.z = cvt_pk_bf16(silu_f(g1[0]) * u1[0], silu_f(g1[1]) * u1[1]); w.w = cvt_pk_bf16(silu_f(g1[2]) * u1[2], silu_f(g1[3]) * u1[3]);
                *(u32x4*)rowp = w; }
    }
};
struct EpiY { static constexpr bool PERM = true, AFTER_DRAIN = false; bf16_t* O; float* ss;
    __device__ __forceinline__ void operator()(const f32x4 (&acc)[2][2][4][2], const Unit& u, int wr, int wc, int fr, int fq) const {
        const int row0 = u.pm * BM + wr * 64 + fr, col0 = u.pn * BM + wc * 32 + 8 * fq;
#pragma unroll
        for (int ai = 0; ai < 2; ++ai)
#pragma unroll
            for (int m = 0; m < 4; ++m) { const int row = row0 + ai * HALF + m * 16; bf16_t* rowp = O + (size_t)row * 1024 + col0; float s = 0.f;
#pragma unroll
                for (int bj = 0; bj < 2; ++bj) { const f32x4 v0 = acc[ai][bj][m][0], v1 = acc[ai][bj][m][1];
                    s += (v0[0] * v0[0] + v0[1] * v0[1]) + (v0[2] * v0[2] + v0[3] * v0[3]) + (v1[0] * v1[0] + v1[1] * v1[1]) + (v1[2] * v1[2] + v1[3] * v1[3]);
                    u32x4 w; w.x = cvt_pk_bf16(v0[0], v0[1]); w.y = cvt_pk_bf16(v0[2], v0[3]); w.z = cvt_pk_bf16(v1[0], v1[1]); w.w = cvt_pk_bf16(v1[2], v1[3]);
                    *(u32x4*)(rowp + bj * HALF) = w; }
                s += __shfl_xor(s, 16); s += __shfl_xor(s, 32);
                if (fq == 0) ss[(size_t)row * SS_LD + u.pn * 4 + wc] = s; }
    }
};
struct EpiDaQkv { static constexpr bool PERM = true, AFTER_DRAIN = false; bf16_t* O; const float* rope;
    __device__ __forceinline__ void operator()(const f32x4 (&acc)[2][2][4][2], const Unit& u, int wr, int wc, int fr, int fq) const {
        const int row0 = u.pm * BM + wr * 64 + fr, col0 = u.pn * BM + wc * 32 + 8 * fq;
        const bool rp = (u.pn < 8) && (u.pm < 128);
#pragma unroll
        for (int ai = 0; ai < 2; ++ai)
#pragma unroll
            for (int m = 0; m < 4; ++m) { const int row = row0 + ai * HALF + m * 16; bf16_t* rowp = O + (size_t)row * 3072 + col0;
                if (rp) { const int t = row & 4095, pos = (wc & 1) ? (t & 63) : (t >> 6); const f32x4* rpp = (const f32x4*)(rope + (size_t)(pos * 16 + 4 * fq) * 2); const f32x4 c01 = rpp[0], c23 = rpp[1];
#pragma unroll
                    for (int bj = 0; bj < 2; ++bj) { const f32x4 v0 = acc[ai][bj][m][0], v1 = acc[ai][bj][m][1];
                        u32x4 w;
                        w.x = cvt_pk_bf16(v0[0] * c01[0] - v0[1] * c01[1], v0[0] * c01[1] + v0[1] * c01[0]);
                        w.y = cvt_pk_bf16(v0[2] * c01[2] - v0[3] * c01[3], v0[2] * c01[3] + v0[3] * c01[2]);
                        w.z = cvt_pk_bf16(v1[0] * c23[0] - v1[1] * c23[1], v1[0] * c23[1] + v1[1] * c23[0]);
                        w.w = cvt_pk_bf16(v1[2] * c23[2] - v1[3] * c23[3], v1[2] * c23[3] + v1[3] * c23[2]);
                        *(u32x4*)(rowp + bj * HALF) = w; } }
                else {
#pragma unroll
                    for (int bj = 0; bj < 2; ++bj) { const f32x4 v0 = acc[ai][bj][m][0], v1 = acc[ai][bj][m][1];
                        u32x4 w; w.x = cvt_pk_bf16(v0[0], v0[1]); w.y = cvt_pk_bf16(v0[2], v0[3]); w.z = cvt_pk_bf16(v1[0], v1[1]); w.w = cvt_pk_bf16(v1[2], v1[3]);
                        *(u32x4*)(rowp + bj * HALF) = w; } } }
    }
};
struct EpiGqaQkv { static constexpr bool PERM = true, AFTER_DRAIN = false; bf16_t* O; float* ss;
    __device__ __forceinline__ void operator()(const f32x4 (&acc)[2][2][4][2], const Unit& u, int wr, int wc, int fr, int fq) const {
        const int row0 = u.pm * BM + wr * 64 + fr, col0 = u.pn * BM + wc * 32 + 8 * fq;
#pragma unroll
        for (int ai = 0; ai < 2; ++ai)
#pragma unroll
            for (int m = 0; m < 4; ++m) { const int row = row0 + ai * HALF + m * 16; bf16_t* rowp = O + (size_t)row * 1536 + col0;
#pragma unroll
                for (int bj = 0; bj < 2; ++bj) { const f32x4 v0 = acc[ai][bj][m][0], v1 = acc[ai][bj][m][1];
                    float s = (v0[0] * v0[0] + v0[1] * v0[1]) + (v0[2] * v0[2] + v0[3] * v0[3]) + (v1[0] * v1[0] + v1[1] * v1[1]) + (v1[2] * v1[2] + v1[3] * v1[3]);
                    u32x4 w; w.x = cvt_pk_bf16(v0[0], v0[1]); w.y = cvt_pk_bf16(v0[2], v0[3]); w.z = cvt_pk_bf16(v1[0], v1[1]); w.w = cvt_pk_bf16(v1[2], v1[3]);
                    *(u32x4*)(rowp + bj * HALF) = w;
                    s += __shfl_xor(s, 16); s += __shfl_xor(s, 32);
                    const int head = 2 * u.pn + bj;
                    if (fq == 0 && head < 10) ss[(size_t)row * SS_LD + head * 4 + wc] = s; } }
    }
};
struct EpiHg { static constexpr bool PERM = true, AFTER_DRAIN = false; bf16_t* O; const float* lb;
    __device__ __forceinline__ void operator()(const f32x4 (&acc)[2][2][4][2], const Unit& u, int wr, int wc, int fr, int fq) const {
        const int row0 = u.pm * BM + wr * 64 + fr, col0 = u.pn * BM + wc * 32 + 8 * fq;
        const int sec = u.pn >> 2, ch0 = (u.pn & 3) * BM + wc * 32 + 8 * fq;
        f32x4 l0[2], l1[2];
#pragma unroll
        for (int bj = 0; bj < 2; ++bj) { l0[bj] = (f32x4){0.f, 0.f, 0.f, 0.f}; l1[bj] = l0[bj];
            if (sec == 1 || sec == 2) { const f32x4* lp = (const f32x4*)(lb + (sec - 1) * 1024 + ch0 + bj * HALF); l0[bj] = lp[0]; l1[bj] = lp[1]; } }
#pragma unroll
        for (int ai = 0; ai < 2; ++ai)
#pragma unroll
            for (int m = 0; m < 4; ++m) { const int row = row0 + ai * HALF + m * 16; bf16_t* rowp = O + (size_t)row * 5120 + col0;
#pragma unroll
                for (int bj = 0; bj < 2; ++bj) { f32x4 v0 = acc[ai][bj][m][0], v1 = acc[ai][bj][m][1];
                    if (sec == 0 || sec == 4) {
#pragma unroll
                        for (int e = 0; e < 4; ++e) { v0[e] = silu_f(v0[e]); v1[e] = silu_f(v1[e]); } }
                    else if (sec == 1 || sec == 2) {
#pragma unroll
                        for (int e = 0; e < 4; ++e) { v0[e] = (1.f - l0[bj][e]) * sigm_f(-v0[e]); v1[e] = (1.f - l1[bj][e]) * sigm_f(-v1[e]); } }
                    u32x4 w; w.x = cvt_pk_bf16(v0[0], v0[1]); w.y = cvt_pk_bf16(v0[2], v0[3]); w.z = cvt_pk_bf16(v1[0], v1[1]); w.w = cvt_pk_bf16(v1[2], v1[3]);
                    *(u32x4*)(rowp + bj * HALF) = w; } }
    }
};
struct EpiPart { static constexpr bool PERM = true, AFTER_DRAIN = false; bf16_t* Phi;
    __device__ __forceinline__ void operator()(const f32x4 (&acc)[2][2][4][2], const Unit& u, int wr, int wc, int fr, int fq) const {
        const int row0 = (u.pm - 128) * BM + wr * 64 + fr, col0 = u.pn * BM + wc * 32 + 8 * fq;
#pragma unroll
        for (int ai = 0; ai < 2; ++ai)
#pragma unroll
            for (int m = 0; m < 4; ++m) { bf16_t* rowp = Phi + (size_t)(row0 + ai * HALF + m * 16) * 1024 + col0;
#pragma unroll
                for (int bj = 0; bj < 2; ++bj) { const f32x4 v0 = acc[ai][bj][m][0], v1 = acc[ai][bj][m][1];
                    u32x4 w; w.x = cvt_pk_bf16(v0[0], v0[1]); w.y = cvt_pk_bf16(v0[2], v0[3]); w.z = cvt_pk_bf16(v1[0], v1[1]); w.w = cvt_pk_bf16(v1[2], v1[3]);
                    *(u32x4*)(rowp + bj * HALF) = w;
                    u32x4 l;
                    l.x = cvt_pk_bf16(v0[0] - __builtin_bit_cast(float, w.x << 16), v0[1] - __builtin_bit_cast(float, w.x & 0xffff0000u));
                    l.y = cvt_pk_bf16(v0[2] - __builtin_bit_cast(float, w.y << 16), v0[3] - __builtin_bit_cast(float, w.y & 0xffff0000u));
                    l.z = cvt_pk_bf16(v1[0] - __builtin_bit_cast(float, w.z << 16), v1[1] - __builtin_bit_cast(float, w.z & 0xffff0000u));
                    l.w = cvt_pk_bf16(v1[2] - __builtin_bit_cast(float, w.w << 16), v1[3] - __builtin_bit_cast(float, w.w & 0xffff0000u));
                    *(u32x4*)(rowp + (size_t)2048 * 1024 + bj * HALF) = l; } }
    }
};

template <class Epi, class Sched, bool ALIGN_EPI = false, bool SP2 = false>
__device__ __forceinline__ void gemm_phase(PG8_LAS unsigned char* lds, const Gemm g, const Sched& S, const Epi& E, int wave_s) {
    const int tid_l = my_tid(wave_s);
    const int tid = tid_l, wid = __builtin_amdgcn_readfirstlane(tid >> 6), lane = tid & 63, wr = wid >> 2, wc = wid & 3, fr = lane & 15, fq = lane >> 4;
    const int K = g.ld ? g.ld : g.K, nt = g.K / BK;
    unsigned voffA[2], voffB[2];
#pragma unroll
    for (int i = 0; i < 2; ++i) { int R, C; stage_rc(tid * 16 + i * 8192, R, C); const int Rb = Epi::PERM ? ((R & ~31) + perm32(R & 31)) : R;
        voffA[i] = (unsigned)(R * K + C) * 2u; voffB[i] = (unsigned)(Rb * K + C) * 2u; }
    const size_t kstep = (size_t)(BK * 2);
    const size_t hstep = (size_t)HALF * K * 2;
    const size_t tstep = 2 * hstep;
    const unsigned ldsw = (unsigned)wid * 1024u;
    const int aoff = lds_byte(wr * 64 + fr, fq * 8), boff = lds_byte(wc * 32 + fr, fq * 8);
#define PG8_SA(b, h) (((b) * 2 + (h)) * HTB)
#define PG8_SB(b, h) ((4 + (b) * 2 + (h)) * HTB)
#define PG8_STAGE(bufoff, gbase, voff) do { _Pragma("unroll") for (int _i = 0; _i < 2; ++_i) \
        __builtin_amdgcn_global_load_lds((const unsigned*)((const char*)(gbase) + (voff)[_i]), (PG8_LAS unsigned*)(lds + (bufoff) + ldsw + _i * 8192), 16, 0, 0); } while (0)
#define PG8_LDA(dst, b, h) do { _Pragma("unroll") for (int m = 0; m < 4; ++m) _Pragma("unroll") for (int k = 0; k < 2; ++k) dst[m][k] = *(const PG8_LAS bf16x8*)(lds + PG8_SA(b, h) + aoff + m * 2048 + k * 1024); } while (0)
#define PG8_LDB(dst, b, h) do { _Pragma("unroll") for (int n = 0; n < 2; ++n) _Pragma("unroll") for (int k = 0; k < 2; ++k) dst[n][k] = *(const PG8_LAS bf16x8*)(lds + PG8_SB(b, h) + boff + n * 2048 + k * 1024); } while (0)
#define PG8_MMA(ai, bj, At, Bt) do { __builtin_amdgcn_s_setprio(1); _Pragma("unroll") for (int m = 0; m < 4; ++m) _Pragma("unroll") for (int n = 0; n < 2; ++n) _Pragma("unroll") for (int k = 0; k < 2; ++k) \
        acc[ai][bj][m][n] = __builtin_amdgcn_mfma_f32_16x16x32_bf16(Bt[n][k], At[m][k], acc[ai][bj][m][n], 0, 0, 0); __builtin_amdgcn_s_setprio(0); } while (0)
#define PG8_WAIT_V(n) asm volatile("s_waitcnt vmcnt(" #n ")" ::: "memory")
#define PG8_WAIT_L(n) asm volatile("s_waitcnt lgkmcnt(" #n ")" ::: "memory")
#define PG8_BAR __builtin_amdgcn_s_barrier()
#define PG8_SCHED __builtin_amdgcn_sched_barrier(0)
    float z0 = 0.f; asm volatile("" : "+v"(z0)); const f32x4 zacc = (f32x4){z0, z0, z0, z0};
    Unit cur, nxt; int ui = 0;
    if (!S.next(0, cur)) return;
    f32x4 acc[2][2][4][2];
#pragma unroll
    for (int a = 0; a < 2; ++a)
#pragma unroll
        for (int b = 0; b < 2; ++b)
#pragma unroll
            for (int m = 0; m < 4; ++m)
#pragma unroll
                for (int n = 0; n < 2; ++n) acc[a][b][m][n] = zacc;
    bf16x8 At[4][2], B0[2][2], B1[2][2];
    const char* cA = (const char*)g.A + (size_t)cur.pm * tstep; const char* cB = (const char*)g.Bt + (size_t)cur.pn * tstep;
    S.a_ready(cur);
    if constexpr (SP2) {
        PG8_STAGE(PG8_SB(0, 0), cB, voffB); PG8_STAGE(PG8_SB(0, 1), cB + hstep, voffB); PG8_STAGE(PG8_SA(0, 0), cA, voffA); PG8_STAGE(PG8_SA(0, 1), cA + hstep, voffA);
        if (wr == 1) PG8_BAR;
        PG8_WAIT_V(2); PG8_BAR;
        PG8_STAGE(PG8_SB(1, 0), cB + kstep, voffB); PG8_STAGE(PG8_SA(1, 0), cA + kstep, voffA); PG8_STAGE(PG8_SB(1, 1), cB + hstep + kstep, voffB);
        PG8_WAIT_V(6); PG8_BAR;
    } else {
        PG8_STAGE(PG8_SB(0, 0), cB, voffB); PG8_STAGE(PG8_SA(0, 0), cA, voffA); PG8_STAGE(PG8_SB(0, 1), cB + hstep, voffB); PG8_STAGE(PG8_SA(0, 1), cA + hstep, voffA);
        if (wr == 1) PG8_BAR;
        PG8_WAIT_V(4); PG8_BAR;
        PG8_STAGE(PG8_SB(1, 0), cB + kstep, voffB); PG8_STAGE(PG8_SA(1, 0), cA + kstep, voffA); PG8_STAGE(PG8_SB(1, 1), cB + hstep + kstep, voffB);
        PG8_WAIT_V(6); PG8_BAR;
    }
    for (;;) {
        const bool has_next = S.next(ui + 1, nxt);
        const char* nA = has_next ? (const char*)g.A + (size_t)nxt.pm * tstep : cA; const char* nB = has_next ? (const char*)g.Bt + (size_t)nxt.pn * tstep : cB;
        for (int t = 0; t < nt; t += 2) {
            const bool last = (t == nt - 2);
            const char* a1 = cA + (size_t)(t + 1) * kstep;
            const char* a2 = last ? nA : cA + (size_t)(t + 2) * kstep; const char* b2 = last ? nB : cB + (size_t)(t + 2) * kstep;
            const char* a3 = a2 + kstep; const char* b3 = b2 + kstep;
            if (last && has_next) S.a_ready(nxt);
            if constexpr (SP2) {
            PG8_LDB(B0, 0, 0); PG8_LDB(B1, 0, 1); PG8_SCHED; PG8_LDA(At, 0, 0); PG8_STAGE(PG8_SA(1, 1), a1 + hstep, voffA);
            PG8_WAIT_V(8); PG8_WAIT_L(0); PG8_BAR; PG8_MMA(0, 0, At, B0); PG8_MMA(0, 1, At, B1); PG8_BAR; PG8_SCHED;
            PG8_LDA(At, 0, 1); PG8_STAGE(PG8_SB(0, 0), b2, voffB); PG8_STAGE(PG8_SB(0, 1), b2 + hstep, voffB); PG8_STAGE(PG8_SA(0, 0), a2, voffA);
            PG8_WAIT_V(8); PG8_WAIT_L(0); PG8_BAR; PG8_MMA(1, 0, At, B0); PG8_MMA(1, 1, At, B1); PG8_BAR; PG8_SCHED;
            PG8_LDB(B0, 1, 0); PG8_LDB(B1, 1, 1); PG8_SCHED; PG8_LDA(At, 1, 0); PG8_STAGE(PG8_SA(0, 1), a2 + hstep, voffA);
            PG8_WAIT_V(8); PG8_WAIT_L(0); PG8_BAR; PG8_MMA(0, 0, At, B0); PG8_MMA(0, 1, At, B1); PG8_BAR; PG8_SCHED;
            PG8_LDA(At, 1, 1); PG8_STAGE(PG8_SB(1, 0), b3, voffB); PG8_STAGE(PG8_SB(1, 1), b3 + hstep, voffB); PG8_STAGE(PG8_SA(1, 0), a3, voffA);
            PG8_WAIT_V(8); PG8_WAIT_L(0); PG8_BAR; PG8_MMA(1, 0, At, B0); PG8_MMA(1, 1, At, B1); PG8_BAR; PG8_SCHED;
            } else {
            PG8_LDB(B0, 0, 0); PG8_SCHED; PG8_LDA(At, 0, 0); PG8_STAGE(PG8_SA(1, 1), a1 + hstep, voffA);
            PG8_WAIT_L(8); PG8_BAR; PG8_WAIT_L(0); PG8_MMA(0, 0, At, B0); PG8_BAR; PG8_SCHED;
            PG8_LDB(B1, 0, 1); PG8_STAGE(PG8_SB(0, 0), b2, voffB);
            PG8_BAR; PG8_WAIT_L(0); PG8_MMA(0, 1, At, B1); PG8_BAR;
            PG8_LDA(At, 0, 1); PG8_STAGE(PG8_SA(0, 0), a2, voffA);
            PG8_BAR; PG8_WAIT_L(0); PG8_MMA(1, 0, At, B0); PG8_BAR; PG8_SCHED;
            PG8_STAGE(PG8_SB(0, 1), b2 + hstep, voffB);
            PG8_WAIT_V(6); PG8_BAR; PG8_MMA(1, 1, At, B1); PG8_BAR;
            PG8_LDB(B0, 1, 0); PG8_SCHED; PG8_LDA(At, 1, 0); PG8_STAGE(PG8_SA(0, 1), a2 + hstep, voffA);
            PG8_WAIT_L(8); PG8_BAR; PG8_WAIT_L(0); PG8_MMA(0, 0, At, B0); PG8_BAR; PG8_SCHED;
            PG8_LDB(B1, 1, 1); PG8_STAGE(PG8_SB(1, 0), b3, voffB);
            PG8_BAR; PG8_WAIT_L(0); PG8_MMA(0, 1, At, B1); PG8_BAR;
            PG8_LDA(At, 1, 1); PG8_STAGE(PG8_SA(1, 0), a3, voffA);
            PG8_BAR; PG8_WAIT_L(0); PG8_MMA(1, 0, At, B0); PG8_BAR; PG8_SCHED;
            PG8_STAGE(PG8_SB(1, 1), b3 + hstep, voffB);
            PG8_WAIT_V(6); PG8_BAR; PG8_MMA(1, 1, At, B1); PG8_BAR;
            }
        }
        if constexpr (ALIGN_EPI) { if (wr == 0) PG8_BAR; }
        if constexpr (!Epi::AFTER_DRAIN) { E(acc, cur, wr, wc, fr, fq); S.done(cur); }
        if (!has_next) break;
#pragma unroll
        for (int a = 0; a < 2; ++a)
#pragma unroll
            for (int b = 0; b < 2; ++b)
#pragma unroll
                for (int m = 0; m < 4; ++m)
#pragma unroll
                    for (int n = 0; n < 2; ++n) acc[a][b][m][n] = zacc;
        cur = nxt; cA = nA; cB = nB; ++ui;
        if constexpr (ALIGN_EPI) { if (wr == 1) PG8_BAR; }
    }
    PG8_WAIT_V(0);
    if constexpr (!ALIGN_EPI) { if (wr == 0) PG8_BAR; }
    PG8_BAR;
    if constexpr (Epi::AFTER_DRAIN) { E.fused(acc, cur, wr, wc, fr, fq, lds, wid, lane); S.done(cur); }
#undef PG8_SA
#undef PG8_SB
#undef PG8_STAGE
#undef PG8_LDA
#undef PG8_LDB
#undef PG8_MMA
#undef PG8_WAIT_V
#undef PG8_WAIT_L
#undef PG8_BAR
#undef PG8_SCHED
}
}
namespace att {
typedef unsigned short bf16;
using bf16x8 = __attribute__((ext_vector_type(8))) short;
using s16x4  = __attribute__((ext_vector_type(4))) short;
using f32x16 = __attribute__((ext_vector_type(16))) float;
using u32x4  = __attribute__((ext_vector_type(4))) unsigned;
constexpr int NW = 8, QBLK = 32, KVBLK = 64;
constexpr float THR = 8.f;
constexpr int SDEPTH = 2;
constexpr size_t SHM_V = KVBLK * 128 * 2, SHM_K = KVBLK * 128 * 2, SHM_ATTN = 3 * SHM_V + 2 * SHM_K + NW * 64 * 4;
#define KSWZ(row, colB) ((row) * 256 + ((colB) ^ (((row) & 7) << 4)))
#define SBAR() __builtin_amdgcn_sched_barrier(0)
__device__ __forceinline__ int crow(int r, int hi) { return (r & 3) + 8 * (r >> 2) + 4 * hi; }
__device__ __forceinline__ unsigned cvtpk(float lo, float hi) { unsigned r; asm volatile("v_cvt_pk_bf16_f32 %0, %1, %2" : "=v"(r) : "v"(lo), "v"(hi)); return r; }
__device__ __forceinline__ bf16x8 ld8(const bf16* p) { return *reinterpret_cast<const bf16x8*>(p); }

template <int DQK>
__device__ __forceinline__ void partialSM(f32x16& p0, f32x16& p1, float& m_reg, float& mn, float& alpha) {
  constexpr float SCALE = (DQK == 64) ? 0.125f : 0.088388347648318440f;
  constexpr float C = SCALE * 1.4426950408889634f;
  float pmax = p0[0];
#pragma unroll
  for (int r = 1; r < 16; ++r) pmax = fmaxf(pmax, p0[r]);
#pragma unroll
  for (int r = 0; r < 16; ++r) pmax = fmaxf(pmax, p1[r]);
  { auto rr = __builtin_amdgcn_permlane32_swap(__float_as_uint(pmax), __float_as_uint(pmax), false, false);
    pmax = fmaxf(__uint_as_float(rr[0]), __uint_as_float(rr[1])); }
  if (__builtin_expect(__all(pmax - m_reg <= THR / SCALE), 1)) { mn = m_reg; alpha = 1.f; }
  else { mn = fmaxf(m_reg, pmax); alpha = __builtin_amdgcn_exp2f((m_reg - mn) * C); m_reg = mn; }
  float mnC = -mn * C;
#pragma unroll
  for (int r = 0; r < 16; ++r) p0[r] = fmaf(p0[r], C, mnC);
#pragma unroll
  for (int r = 0; r < 16; ++r) p1[r] = fmaf(p1[r], C, mnC);
#pragma unroll
  for (int r = 0; r < 16; ++r) p0[r] = __builtin_amdgcn_exp2f(p0[r]);
}
__device__ __forceinline__ void finishSM(f32x16& p0, f32x16& p1, float alpha, float& l_reg, bf16x8& pa0, bf16x8& pa1, bf16x8& pa2, bf16x8& pa3) {
#pragma unroll
  for (int r = 0; r < 16; ++r) p1[r] = __builtin_amdgcn_exp2f(p1[r]);
  float ps = 0;
#pragma unroll
  for (int r = 0; r < 16; ++r) ps += p0[r];
#pragma unroll
  for (int r = 0; r < 16; ++r) ps += p1[r];
  { auto rr = __builtin_amdgcn_permlane32_swap(__float_as_uint(ps), __float_as_uint(ps), false, false);
    ps = __uint_as_float(rr[0]) + __uint_as_float(rr[1]); }
  l_reg = l_reg * alpha + ps;
#define PK4(P, BASE, OUT) do { unsigned a0 = cvtpk(P[BASE + 0], P[BASE + 1]), a1 = cvtpk(P[BASE + 2], P[BASE + 3]);   \
    unsigned b0 = cvtpk(P[BASE + 4], P[BASE + 5]), b1 = cvtpk(P[BASE + 6], P[BASE + 7]);                              \
    auto r0 = __builtin_amdgcn_permlane32_swap(a0, b0, false, false); auto r1 = __builtin_amdgcn_permlane32_swap(a1, b1, false, false); \
    u32x4 w = {r0[0], r1[0], r0[1], r1[1]}; OUT = *reinterpret_cast<bf16x8*>(&w); } while (0)
  PK4(p0, 0, pa0); PK4(p0, 8, pa1); PK4(p1, 0, pa2); PK4(p1, 8, pa3);
#undef PK4
}
template <int DQK>
__device__ __forceinline__ void qkt(f32x16& p0, f32x16& p1, const char* Ks, const bf16x8* qr, int r32, int hi, int kcolB) {
  p0 = f32x16{}; p1 = f32x16{};
#pragma unroll
  for (int d0 = 0; d0 < DQK / 16; ++d0) { int cb = kcolB + (d0 * 16 + hi * 8) * 2;
    bf16x8 b0 = *reinterpret_cast<const bf16x8*>(Ks + KSWZ(r32, cb));
    bf16x8 b1 = *reinterpret_cast<const bf16x8*>(Ks + KSWZ(32 + r32, cb));
    p0 = __builtin_amdgcn_mfma_f32_32x32x16_bf16(b0, qr[d0], p0, 0, 0, 0);
    p1 = __builtin_amdgcn_mfma_f32_32x32x16_bf16(b1, qr[d0], p1, 0, 0, 0); }
}
__device__ __forceinline__ int v_st(int k, int c) { const int kk = (k & ~0xC) | ((k & 4) << 1) | ((k & 8) >> 1); return ((kk >> 3) * 4 + (c >> 5)) * 512 + ((kk & 7) * 32 + (c & 31)) * 2; }
__device__ __forceinline__ int v_rd_base(int lane) { return ((lane & 3) << 3) | (((lane >> 2) & 3) << 6) | (((lane >> 4) & 1) << 5) | (((lane >> 5) & 1) << 8); }
constexpr int v_rd_off(int d0, int ks, int half) { return d0 * 512 + ks * 4096 + half * 2048; }
template <int OFF> __device__ __forceinline__ s16x4 tr_read(int vb) {
  s16x4 r; asm volatile("ds_read_b64_tr_b16 %0, %1 offset:%2" : "=&v"(r) : "v"(vb), "i"(OFF) : "memory"); return r;
}
template <int D0> __device__ __forceinline__ void pv_one(f32x16& od, int vb, bf16x8 pa0, bf16x8 pa1, bf16x8 pa2, bf16x8 pa3) {
  const s16x4 l0 = tr_read<v_rd_off(D0, 0, 0)>(vb), h0 = tr_read<v_rd_off(D0, 0, 1)>(vb), l1 = tr_read<v_rd_off(D0, 1, 0)>(vb), h1 = tr_read<v_rd_off(D0, 1, 1)>(vb);
  const s16x4 l2 = tr_read<v_rd_off(D0, 2, 0)>(vb), h2 = tr_read<v_rd_off(D0, 2, 1)>(vb), l3 = tr_read<v_rd_off(D0, 3, 0)>(vb), h3 = tr_read<v_rd_off(D0, 3, 1)>(vb);
  asm volatile("s_waitcnt lgkmcnt(0)" ::: "memory"); SBAR();
#define PK(L, H) (bf16x8){L[0], L[1], L[2], L[3], H[0], H[1], H[2], H[3]}
  od = __builtin_amdgcn_mfma_f32_32x32x16_bf16(pa0, PK(l0, h0), od, 0, 0, 0);
  od = __builtin_amdgcn_mfma_f32_32x32x16_bf16(pa1, PK(l1, h1), od, 0, 0, 0);
  od = __builtin_amdgcn_mfma_f32_32x32x16_bf16(pa2, PK(l2, h2), od, 0, 0, 0);
  od = __builtin_amdgcn_mfma_f32_32x32x16_bf16(pa3, PK(l3, h3), od, 0, 0, 0);
#undef PK
}
__device__ __forceinline__ void pv_d0(f32x16* o, int vb, bf16x8 pa0, bf16x8 pa1, bf16x8 pa2, bf16x8 pa3) {
  pv_one<0>(o[0], vb, pa0, pa1, pa2, pa3); pv_one<1>(o[1], vb, pa0, pa1, pa2, pa3); pv_one<2>(o[2], vb, pa0, pa1, pa2, pa3); pv_one<3>(o[3], vb, pa0, pa1, pa2, pa3);
}

template <int DQK, int LDQ, int LDK, int LDO, int MODE>
__device__ __forceinline__ void attn_unit(const bf16* __restrict__ Qb, const bf16* __restrict__ K1, const bf16* __restrict__ V1, int n1,
                                          const bf16* __restrict__ K2, const bf16* __restrict__ V2, int seq, int kcolB, bf16* __restrict__ Ob, char* lds, int wave_s,
                                          float* stash, float lam, float oml, const float* subln) {
  const int tid_l = my_tid(wave_s);
  const int tid = tid_l, wid = tid >> 6, lane = tid & 63, r32 = lane & 31, hi = lane >> 5;
  char* V_lds = lds; char* K_lds = lds + 3 * SHM_V;
  float* ws = (float*)(lds + 3 * SHM_V + 2 * SHM_K) + wid * 64; float* li_l = ws; float* al_l = ws + 32;
  float m_reg = -1e30f, l_reg = 0; f32x16 o[4] = {}; bf16x8 qr[DQK / 16];
  const bf16* Qw = Qb + (long)(wid * QBLK + r32) * LDQ + hi * 8;
#pragma unroll
  for (int d0 = 0; d0 < DQK / 16; ++d0) qr[d0] = ld8(Qw + d0 * 16);
  const int sr = tid >> 4, sc = (tid & 15) * 8, vst0 = v_st(sr, sc), vst1 = v_st(32 + sr, sc);
  const int vb0 = (int)(uintptr_t)V_lds + v_rd_base(lane);
  struct { bf16x8 vs0, vs1, ks0, ks1; } sr_[SDEPTH];
  const int kr = tid >> 3, kcb = kcolB + (tid & 7) * 16;
#define SLOAD(i, k0) do { const int _k0 = (k0); const bool _s1 = _k0 < n1; const int _kk = _s1 ? _k0 : _k0 - n1; const long _off = (long)(_kk + sr) * LDK + sc; \
    const bf16* _vp = (_s1 ? V1 : V2) + _off; sr_[i].vs0 = ld8(_vp); sr_[i].vs1 = ld8(_vp + 32 * LDK); \
    if constexpr (DQK == 64) { sr_[i].ks0 = ld8((_s1 ? K1 : K2) + (long)(_kk + kr) * LDK + (kcb >> 1)); } \
    else { const bf16* _kp = (_s1 ? K1 : K2) + _off; sr_[i].ks0 = ld8(_kp); sr_[i].ks1 = ld8(_kp + 32 * LDK); } } while (0)
#define SWRITE(b, vsl, i) do { *(bf16x8*)(V_lds + (vsl) * (int)SHM_V + vst0) = sr_[i].vs0;          \
    *(bf16x8*)(V_lds + (vsl) * (int)SHM_V + vst1) = sr_[i].vs1; int kc = sc * 2;               \
    if constexpr (DQK == 64) { *(bf16x8*)(K_lds + (b) * SHM_K + KSWZ(kr, kcb)) = sr_[i].ks0; } \
    else { *(bf16x8*)(K_lds + (b) * SHM_K + KSWZ(sr, kc)) = sr_[i].ks0;                       \
    *(bf16x8*)(K_lds + (b) * SHM_K + KSWZ(32 + sr, kc)) = sr_[i].ks1; } } while (0)
#define SWAIT() do { if constexpr (DQK == 64) asm volatile("s_waitcnt vmcnt(3)" ::: "memory"); else asm volatile("s_waitcnt vmcnt(4)" ::: "memory"); } while (0)
#define RESC(a) do { if (__any((a) < 1.f)) { if (hi == 0) al_l[r32] = (a); asm volatile("s_waitcnt lgkmcnt(0)" ::: "memory"); \
    _Pragma("unroll") for (int d = 0; d < 4; ++d) _Pragma("unroll") for (int r = 0; r < 16; ++r) o[d][r] *= al_l[crow(r, hi)]; } } while (0)
  f32x16 pA0, pA1, pB0, pB1; float mnA, mnB, alA, alB; bf16x8 pa0, pa1, pa2, pa3; const int NT = seq / KVBLK;
  constexpr int SE = 0, SO = SDEPTH - 1;
  __syncthreads();
  int vp = 0, vc = 1, vn = 2;
  SLOAD(SE, 0); SLOAD(SO, KVBLK); SWAIT(); SWRITE(0, 0, SE); __syncthreads();
  qkt<DQK>(pA0, pA1, K_lds, qr, r32, hi, kcolB); partialSM<DQK>(pA0, pA1, m_reg, mnA, alA);
  if (2 < NT) SLOAD(SE, 2 * KVBLK);
  SWAIT(); SWRITE(1, 1, SO); __syncthreads();
  for (int j = 1; j + 1 < NT; j += 2) {
    SBAR(); qkt<DQK>(pB0, pB1, K_lds + SHM_K, qr, r32, hi, kcolB);
    finishSM(pA0, pA1, alA, l_reg, pa0, pa1, pa2, pa3); SBAR();
    SLOAD(SO, (j + SDEPTH) * KVBLK); SBAR();
    pv_d0(o, vb0 + vp * (int)SHM_V, pa0, pa1, pa2, pa3); partialSM<DQK>(pB0, pB1, m_reg, mnB, alB);
    SWAIT(); SWRITE(0, vn, SE);
    RESC(alB); __syncthreads();
    { const int t_ = vp; vp = vc; vc = vn; vn = t_; }
    SBAR(); qkt<DQK>(pA0, pA1, K_lds, qr, r32, hi, kcolB);
    finishSM(pB0, pB1, alB, l_reg, pa0, pa1, pa2, pa3); SBAR();
    if (j + 3 < NT) SLOAD(SE, (j + 1 + SDEPTH) * KVBLK); SBAR();
    pv_d0(o, vb0 + vp * (int)SHM_V, pa0, pa1, pa2, pa3); partialSM<DQK>(pA0, pA1, m_reg, mnA, alA);
    SWAIT(); SWRITE(1, vn, SO);
    RESC(alA); __syncthreads();
    { const int t_ = vp; vp = vc; vc = vn; vn = t_; }
  }
  SBAR(); qkt<DQK>(pB0, pB1, K_lds + SHM_K, qr, r32, hi, kcolB);
  finishSM(pA0, pA1, alA, l_reg, pa0, pa1, pa2, pa3); SBAR();
  pv_d0(o, vb0 + vp * (int)SHM_V, pa0, pa1, pa2, pa3); partialSM<DQK>(pB0, pB1, m_reg, mnB, alB);
  RESC(alB);
  finishSM(pB0, pB1, alB, l_reg, pa0, pa1, pa2, pa3); SBAR();
  pv_d0(o, vb0 + vc * (int)SHM_V, pa0, pa1, pa2, pa3);
  if (hi == 0) li_l[r32] = l_reg; asm volatile("s_waitcnt lgkmcnt(0)" ::: "memory");
  float rli[16];
#pragma unroll
  for (int r = 0; r < 16; ++r) rli[r] = __builtin_amdgcn_rcpf(li_l[crow(r, hi)]);
  bf16* Ow = Ob + (long)(wid * QBLK) * LDO;
  if constexpr (MODE == 0) {
#pragma unroll
  for (int r = 0; r < 16; ++r) { int orow = crow(r, hi);
#pragma unroll
    for (int d0 = 0; d0 < 4; ++d0) { const float x = o[d0][r] * rli[r]; Ow[(long)orow * LDO + d0 * 32 + r32] = (bf16)cvtpk(x, x); } }
  } else if constexpr (MODE == 1) {
#pragma unroll
  for (int d0 = 0; d0 < 4; ++d0)
#pragma unroll
    for (int r = 0; r < 16; ++r) stash[(d0 * 16 + r) * 512 + tid] = o[d0][r] * rli[r];
  asm volatile("s_waitcnt vmcnt(0)" ::: "memory");
  } else {
  float gn[4];
#pragma unroll
  for (int d0 = 0; d0 < 4; ++d0) gn[d0] = subln[d0 * 32 + r32] * oml;
#pragma unroll
  for (int r = 0; r < 16; ++r) { const int orow = crow(r, hi); float s = 0.f;
#pragma unroll
    for (int d0 = 0; d0 < 4; ++d0) { const float av = stash[(d0 * 16 + r) * 512 + tid] - lam * (o[d0][r] * rli[r]); o[d0][r] = av; s += av * av; }
    s += __shfl_xor(s, 1); s += __shfl_xor(s, 2); s += __shfl_xor(s, 4); s += __shfl_xor(s, 8); s += __shfl_xor(s, 16);
    const float rinv = 1.f / sqrtf(s * (1.f / 128.f) + 1e-6f);
#pragma unroll
    for (int d0 = 0; d0 < 4; ++d0) { const float x = o[d0][r] * rinv * gn[d0]; Ow[(long)orow * LDO + d0 * 32 + r32] = (bf16)cvtpk(x, x); } }
  }
#undef SLOAD
#undef SWRITE
#undef SWAIT
#undef RESC
}
template <int DQK, int LDQ, int LDK, int LDO>
__device__ __forceinline__ void attn_unit_2b(const bf16* __restrict__ Qb, const bf16* __restrict__ K1, const bf16* __restrict__ V1, int n1,
                                          const bf16* __restrict__ K2, const bf16* __restrict__ V2, int seq, int kcolB, bf16* __restrict__ Ob, char* lds, int wave_s) {
  const int tid_l = my_tid(wave_s);
  const int tid = tid_l, wid = tid >> 6, lane = tid & 63, r32 = lane & 31, hi = lane >> 5;
  char* V_lds = lds; char* K_lds = lds + 2 * SHM_V;
  float* ws = (float*)(lds + 2 * SHM_V + 2 * SHM_K) + wid * 64; float* li_l = ws; float* al_l = ws + 32;
  float m_reg = -1e30f, l_reg = 0; f32x16 o[4] = {}; bf16x8 qr[DQK / 16];
  const bf16* Qw = Qb + (long)(wid * QBLK + r32) * LDQ + hi * 8;
#pragma unroll
  for (int d0 = 0; d0 < DQK / 16; ++d0) qr[d0] = ld8(Qw + d0 * 16);
  const int sr = tid >> 4, sc = (tid & 15) * 8, vst0 = v_st(sr, sc), vst1 = v_st(32 + sr, sc);
  const int vb0 = (int)(uintptr_t)V_lds + v_rd_base(lane);
  struct { bf16x8 vs0, vs1, ks0, ks1; } sr_[SDEPTH];
  const int kr = tid >> 3, kcb = kcolB + (tid & 7) * 16;
#define SLOAD(i, k0) do { const int _k0 = (k0); const bool _s1 = _k0 < n1; const int _kk = _s1 ? _k0 : _k0 - n1; const long _off = (long)(_kk + sr) * LDK + sc; \
    const bf16* _vp = (_s1 ? V1 : V2) + _off; sr_[i].vs0 = ld8(_vp); sr_[i].vs1 = ld8(_vp + 32 * LDK); \
    if constexpr (DQK == 64) { sr_[i].ks0 = ld8((_s1 ? K1 : K2) + (long)(_kk + kr) * LDK + (kcb >> 1)); } \
    else { const bf16* _kp = (_s1 ? K1 : K2) + _off; sr_[i].ks0 = ld8(_kp); sr_[i].ks1 = ld8(_kp + 32 * LDK); } } while (0)
#define SWRITE(b, i) do { *(bf16x8*)(V_lds + (b) * SHM_V + vst0) = sr_[i].vs0;          \
    *(bf16x8*)(V_lds + (b) * SHM_V + vst1) = sr_[i].vs1; int kc = sc * 2;               \
    if constexpr (DQK == 64) { *(bf16x8*)(K_lds + (b) * SHM_K + KSWZ(kr, kcb)) = sr_[i].ks0; } \
    else { *(bf16x8*)(K_lds + (b) * SHM_K + KSWZ(sr, kc)) = sr_[i].ks0;                       \
    *(bf16x8*)(K_lds + (b) * SHM_K + KSWZ(32 + sr, kc)) = sr_[i].ks1; } } while (0)
#define SWAIT() do { if constexpr (DQK == 64) asm volatile("s_waitcnt vmcnt(3)" ::: "memory"); else asm volatile("s_waitcnt vmcnt(4)" ::: "memory"); } while (0)
#define RESC(a) do { if (__any((a) < 1.f)) { if (hi == 0) al_l[r32] = (a); asm volatile("s_waitcnt lgkmcnt(0)" ::: "memory"); \
    _Pragma("unroll") for (int d = 0; d < 4; ++d) _Pragma("unroll") for (int r = 0; r < 16; ++r) o[d][r] *= al_l[crow(r, hi)]; } } while (0)
  f32x16 pA0, pA1, pB0, pB1; float mnA, mnB, alA, alB; bf16x8 pa0, pa1, pa2, pa3; const int NT = seq / KVBLK;
  constexpr int SE = 0, SO = SDEPTH - 1;
  __syncthreads();
  SLOAD(SE, 0); SLOAD(SO, KVBLK); SWAIT(); SWRITE(0, SE); __syncthreads();
  qkt<DQK>(pA0, pA1, K_lds, qr, r32, hi, kcolB); partialSM<DQK>(pA0, pA1, m_reg, mnA, alA);
  if (2 < NT) SLOAD(SE, 2 * KVBLK);
  SWAIT(); SWRITE(1, SO); __syncthreads();
  for (int j = 1; j + 1 < NT; j += 2) {
    SBAR(); qkt<DQK>(pB0, pB1, K_lds + SHM_K, qr, r32, hi, kcolB);
    finishSM(pA0, pA1, alA, l_reg, pa0, pa1, pa2, pa3); SBAR();
    SLOAD(SO, (j + SDEPTH) * KVBLK); SBAR();
    pv_d0(o, vb0, pa0, pa1, pa2, pa3); partialSM<DQK>(pB0, pB1, m_reg, mnB, alB);
    __syncthreads(); SWAIT(); SWRITE(0, SE);
    RESC(alB); __syncthreads();
    SBAR(); qkt<DQK>(pA0, pA1, K_lds, qr, r32, hi, kcolB);
    finishSM(pB0, pB1, alB, l_reg, pa0, pa1, pa2, pa3); SBAR();
    if (j + 3 < NT) SLOAD(SE, (j + 1 + SDEPTH) * KVBLK); SBAR();
    pv_d0(o, vb0 + (int)SHM_V, pa0, pa1, pa2, pa3); partialSM<DQK>(pA0, pA1, m_reg, mnA, alA);
    __syncthreads(); SWAIT(); SWRITE(1, SO);
    RESC(alA); __syncthreads();
  }
  SBAR(); qkt<DQK>(pB0, pB1, K_lds + SHM_K, qr, r32, hi, kcolB);
  finishSM(pA0, pA1, alA, l_reg, pa0, pa1, pa2, pa3); SBAR();
  pv_d0(o, vb0, pa0, pa1, pa2, pa3); partialSM<DQK>(pB0, pB1, m_reg, mnB, alB);
  __syncthreads(); RESC(alB);
  finishSM(pB0, pB1, alB, l_reg, pa0, pa1, pa2, pa3); SBAR();
  pv_d0(o, vb0 + (int)SHM_V, pa0, pa1, pa2, pa3);
  if (hi == 0) li_l[r32] = l_reg; asm volatile("s_waitcnt lgkmcnt(0)" ::: "memory");
  float rli[16];
#pragma unroll
  for (int r = 0; r < 16; ++r) rli[r] = __builtin_amdgcn_rcpf(li_l[crow(r, hi)]);
  bf16* Ow = Ob + (long)(wid * QBLK) * LDO;
#pragma unroll
  for (int r = 0; r < 16; ++r) { int orow = crow(r, hi);
#pragma unroll
    for (int d0 = 0; d0 < 4; ++d0) { const float x = o[d0][r] * rli[r]; Ow[(long)orow * LDO + d0 * 32 + r32] = (bf16)cvtpk(x, x); } }
#undef SLOAD
#undef SWRITE
#undef SWAIT
#undef RESC
}
}
constexpr int NLAT = 32768, NCTX = 2048, NTOK = NLAT + NCTX, DM = 1024, DFF = 2816;
constexpr float EPS = 1e-6f;
constexpr size_t MiB = 1u << 20;
constexpr size_t WS_MOD = 0;
constexpr size_t WS_LB = 1536 * 1024;
constexpr size_t WS_ROPE_DA = WS_LB + 8192;
constexpr size_t WS_ROPE_GQ = WS_ROPE_DA + 8192;
constexpr size_t WS_LAM = WS_ROPE_GQ + 16384;
constexpr size_t WS_SS = 2 * MiB;
constexpr size_t WS_XC = 8 * MiB;
constexpr size_t WS_W = 16 * MiB;
constexpr size_t W_FIN = 0, W_FOUT = W_FIN + (size_t)8 * 5632 * 1024, W_DAQ = W_FOUT + (size_t)8 * 1024 * 2816, W_DAO = W_DAQ + (size_t)2 * 3072 * 1024,
                 W_HGI = W_DAO + (size_t)2 * 1024 * 1024, W_HGO = W_HGI + (size_t)5120 * 1024, W_GQQ = W_HGO + (size_t)1024 * 1024, W_GQO = W_GQQ + (size_t)1536 * 1024,
                 W_END = W_GQO + (size_t)1024 * 1024;
static_assert(WS_W + W_END * 2 <= 184 * MiB, "weights");
constexpr size_t WS_H = 184 * MiB;
constexpr size_t WS_Y = 252 * MiB;
constexpr size_t WS_U = 320 * MiB;
constexpr size_t WS_END = WS_U + (size_t)NTOK * 5120 * 2;
constexpr int LDS_BYTES = 147456;
constexpr int NPHASE = 44;

typedef unsigned short bf16;
typedef float f32x4 __attribute__((ext_vector_type(4)));
typedef unsigned u32x4 __attribute__((ext_vector_type(4)));
typedef unsigned u32x2 __attribute__((ext_vector_type(2)));
typedef short bf16x8 __attribute__((ext_vector_type(8)));
#define LAS __attribute__((address_space(3)))

__device__ __forceinline__ unsigned f2bf(float f) { unsigned u = __builtin_bit_cast(unsigned, f); return (u + 0x7fffu + ((u >> 16) & 1u)) >> 16; }
typedef float f32x2_t __attribute__((ext_vector_type(2))); typedef __bf16 bf16x2_t __attribute__((ext_vector_type(2)));
__device__ __forceinline__ unsigned pk2(float lo, float hi) { const f32x2_t v = {lo, hi}; const bf16x2_t b = __builtin_convertvector(v, bf16x2_t); return __builtin_bit_cast(unsigned, b); }
__device__ __forceinline__ float bf_lo(unsigned w) { return __builtin_bit_cast(float, w << 16); }
__device__ __forceinline__ float bf_hi(unsigned w) { return __builtin_bit_cast(float, w & 0xffff0000u); }
typedef _Float16 h16x2 __attribute__((ext_vector_type(2)));
__device__ __forceinline__ unsigned pkh(float lo, float hi) { const h16x2 h = {(_Float16)lo, (_Float16)hi}; return __builtin_bit_cast(unsigned, h); }
__device__ __forceinline__ float h_lo(unsigned w) { return (float)__builtin_bit_cast(h16x2, w)[0]; }
__device__ __forceinline__ float h_hi(unsigned w) { return (float)__builtin_bit_cast(h16x2, w)[1]; }
__device__ __forceinline__ float wave_sum(float v) {
#pragma unroll
    for (int o = 1; o < 64; o <<= 1) v += __shfl_xor(v, o);
    return v;
}
__device__ __forceinline__ float sum8(float v) { v += __shfl_xor(v, 1); v += __shfl_xor(v, 2); v += __shfl_xor(v, 4); return v; }

struct Args { const float* in[21]; float* out; unsigned char* ws; int ph_lo, ph_hi; };

__device__ __forceinline__ void conv_item(const float* W, int K, int N, bf16* WT, int mode, float* scr, int item, int lane) {
    const int nblk = N / 32, kb = item / nblk, nb = item % nblk, k0 = 64 * kb, n0 = 32 * nb;
    int drow0 = n0;
    if (mode == 1) { const int up = n0 >= DFF, j0 = up ? n0 - DFF : n0; drow0 = (j0 >> 7) * 256 + (j0 & 127) + (up ? 128 : 0); }
    { f32x4 t[8]; const int kr8 = lane >> 3, n4 = (lane & 7) * 4;
#pragma unroll
      for (int i = 0; i < 8; ++i) t[i] = *(const f32x4*)(W + (size_t)(k0 + kr8 + 8 * i) * N + n0 + n4);
#pragma unroll
      for (int i = 0; i < 8; ++i) { float* d = scr + (kr8 + 8 * i) * 33 + n4; d[0] = t[i][0]; d[1] = t[i][1]; d[2] = t[i][2]; d[3] = t[i][3]; } }
    asm volatile("s_waitcnt vmcnt(0) lgkmcnt(0)" ::: "memory");
    const int c = lane & 7;
#pragma unroll
    for (int j = 0; j < 4; ++j) { const int n = (lane >> 3) + 8 * j; const float* s = scr + (8 * c) * 33 + n;
        u32x4 o; o.x = pk2(s[0 * 33], s[1 * 33]); o.y = pk2(s[2 * 33], s[3 * 33]); o.z = pk2(s[4 * 33], s[5 * 33]); o.w = pk2(s[6 * 33], s[7 * 33]);
        *(u32x4*)(WT + (size_t)(drow0 + n) * K + k0 + 8 * c) = o; }
    asm volatile("s_waitcnt lgkmcnt(0)" ::: "memory");
}

struct RowP {
    const void* src_lat; const void* src_ctx; void* dst_lat; void* dst_ctx; int rows; int src_f32, dst_f32;
    int apply; const bf16* Y; const float* ss; const float* g_post; const float* mod_a; int gate_idx; float weight;
    int next; const float* g_pre; const float* mod_n; int shift_idx; bf16* H;
};
__device__ __forceinline__ void row_proc(const float* mod_a, const float* mod_n, const float* g_post, const float* g_pre, void* dst_lat, void* dst_ctx, bf16* Hh, float weight, int gate_idx, int shift_idx, int apply, int next, int src_f32, int dst_f32,
                                         f32x4 (&ca)[4], f32x4 (&cb)[4], f32x4 (&cs)[4], int& cur_m, f32x4 (&v)[4], const u32x2 (&xw)[4], const u32x2 (&yw)[4], float sv, int row, int lane) {
    if (!src_f32) {
#pragma unroll
        for (int j = 0; j < 4; ++j) v[j] = (f32x4){h_lo(xw[j].x), h_hi(xw[j].x), h_lo(xw[j].y), h_hi(xw[j].y)}; }
    const bool lat = row < NLAT; const int mrow = lat ? (row >> 12) : 8;
    if (mrow != cur_m) { cur_m = mrow;
        const float* gate = mod_a + (size_t)mrow * 9216 + gate_idx * 1024; const float* shift = mod_n + (size_t)mrow * 9216 + shift_idx * 1024; const float* scale = shift + 1024;
#pragma unroll
        for (int j = 0; j < 4; ++j) { const int c4 = lane + 64 * j;
            if (apply) { const f32x4 gp = ((const f32x4*)g_post)[c4], gt = ((const f32x4*)gate)[c4]; ca[j] = gp * gt * weight; }
            if (next) { const f32x4 gq = ((const f32x4*)g_pre)[c4], sc = ((const f32x4*)scale)[c4]; cb[j] = gq * (sc + 1.f); cs[j] = ((const f32x4*)shift)[c4]; } } }
    if (apply) {
        const float s = wave_sum(sv);
        const float rinv = 1.f / sqrtf(s * (1.f / DM) + EPS);
        void* const db = lat ? dst_lat : dst_ctx; const size_t o_ = (size_t)(lat ? row : row - NLAT) * DM;
#pragma unroll
        for (int j = 0; j < 4; ++j) { const int c4 = lane + 64 * j;
            v[j][0] += rinv * ca[j][0] * bf_lo(yw[j].x); v[j][1] += rinv * ca[j][1] * bf_hi(yw[j].x);
            v[j][2] += rinv * ca[j][2] * bf_lo(yw[j].y); v[j][3] += rinv * ca[j][3] * bf_hi(yw[j].y);
            if (dst_f32) __builtin_nontemporal_store(v[j], (f32x4*)((float*)db + o_) + c4);
            else { u32x2 xo; xo.x = pkh(v[j][0], v[j][1]); xo.y = pkh(v[j][2], v[j][3]); __builtin_nontemporal_store(xo, (u32x2*)((bf16*)db + o_) + c4);
                   v[j] = (f32x4){h_lo(xo.x), h_hi(xo.x), h_lo(xo.y), h_hi(xo.y)}; } }
    }
    if (next) {
        float s2 = 0.f;
#pragma unroll
        for (int j = 0; j < 4; ++j) s2 += (v[j][0] * v[j][0] + v[j][1] * v[j][1]) + (v[j][2] * v[j][2] + v[j][3] * v[j][3]);
        const float r2 = 1.f / sqrtf(wave_sum(s2) * (1.f / DM) + EPS);
#pragma unroll
        for (int j = 0; j < 4; ++j) { const int c4 = lane + 64 * j;
            u32x2 o; o.x = pk2(v[j][0] * r2 * cb[j][0] + cs[j][0], v[j][1] * r2 * cb[j][1] + cs[j][1]);
            o.y = pk2(v[j][2] * r2 * cb[j][2] + cs[j][2], v[j][3] * r2 * cb[j][3] + cs[j][3]);
            ((u32x2*)(Hh + (size_t)row * DM))[c4] = o; }
    }
}
__device__ __forceinline__ void rowwise(const RowP& p, int rbeg, int rend, int gw, int NGW, int lane) {
    const int per = (rend - rbeg + NGW - 1) / NGW; int row = rbeg + gw * per; const int last = min(rend, row + per);
    if (row >= last) return;
    f32x4 vA[4], vB[4]; u32x2 xA[4], xB[4], xC[4], xD[4], yA[4], yB[4], yC[4], yD[4]; float sA = 0.f, sB = 0.f, sC = 0.f, sD = 0.f;
    const void* const srcL = p.src_lat; const void* const srcC = p.src_ctx; const int sf32 = p.src_f32, df32 = p.dst_f32; const bf16* const Yp = p.Y; const float* const ssp = p.ss; const int app = p.apply;
    const float* const l_ma = p.mod_a; const float* const l_mn = p.mod_n; const float* const l_gpo = p.g_post; const float* const l_gpr = p.g_pre; void* const l_dl = p.dst_lat; void* const l_dc = p.dst_ctx;
    bf16* const l_H = p.H; const float l_w = p.weight; const int l_gi = p.gate_idx, l_si = p.shift_idx, l_nx = p.next;
    f32x4 ca[4], cb[4], cs[4]; int cur_m = -1;
#define VLOAD(V, R) do { const int _r = (R); _Pragma("unroll") for (int j = 0; j < 4; ++j) V[j] = __builtin_nontemporal_load((const f32x4*)((const float*)(_r < NLAT ? srcL : srcC) + (size_t)(_r < NLAT ? _r : _r - NLAT) * DM) + lane + 64 * j); } while (0)
#define RLOAD(V, XW, YW, SV, R) do { const int _r = (R); const void* _sb; size_t _o; if (_r < NLAT) { _sb = srcL; _o = (size_t)_r * DM; } else { _sb = srcC; _o = (size_t)(_r - NLAT) * DM; } \
        if (!sf32) { _Pragma("unroll") for (int j = 0; j < 4; ++j) XW[j] = __builtin_nontemporal_load((const u32x2*)((const bf16*)_sb + _o) + lane + 64 * j); } \
        if (app) { _Pragma("unroll") for (int j = 0; j < 4; ++j) YW[j] = __builtin_nontemporal_load((const u32x2*)(Yp + (size_t)_r * DM) + lane + 64 * j); SV = lane < 16 ? ssp[(size_t)_r * 40 + lane] : 0.f; } } while (0)
    RLOAD(vA, xA, yA, sA, row); if (row + 1 < last) RLOAD(vB, xB, yB, sB, row + 1);
    for (;;) {
        if (row + 2 < last) RLOAD(vA, xC, yC, sC, row + 2);
        if (row + 3 < last) RLOAD(vB, xD, yD, sD, row + 3);
        if (sf32) { VLOAD(vA, row); if (row + 1 < last) VLOAD(vB, row + 1); }
        row_proc(l_ma, l_mn, l_gpo, l_gpr, l_dl, l_dc, l_H, l_w, l_gi, l_si, app, l_nx, sf32, df32, ca, cb, cs, cur_m, vA, xA, yA, sA, row, lane);
        if (row + 1 < last) row_proc(l_ma, l_mn, l_gpo, l_gpr, l_dl, l_dc, l_H, l_w, l_gi, l_si, app, l_nx, sf32, df32, ca, cb, cs, cur_m, vB, xB, yB, sB, row + 1, lane);
        row += 2; if (row >= last) break;
        sA = sC; sB = sD;
#pragma unroll
        for (int j = 0; j < 4; ++j) { xA[j] = xC[j]; yA[j] = yC[j]; xB[j] = xD[j]; yB[j] = yD[j]; }
    }
#undef RLOAD
#undef VLOAD
}

__device__ __forceinline__ void rowwise_ctx(const RowP& p, const bf16* PB, int rbeg, int rend, int gw, int NGW, int lane) {
    for (int row = rbeg + gw; row < rend; row += NGW) {
        const size_t o_ = (size_t)(row - NLAT) * DM;
        f32x4 v[4], y[4]; float s = 0.f;
#pragma unroll
        for (int j = 0; j < 4; ++j) { const int c4 = lane + 64 * j;
            if (p.src_f32) v[j] = ((const f32x4*)((const float*)p.src_ctx + o_))[c4];
            else { const u32x2 w = ((const u32x2*)((const bf16*)p.src_ctx + o_))[c4]; v[j] = (f32x4){h_lo(w.x), h_hi(w.x), h_lo(w.y), h_hi(w.y)}; }
            { f32x4 acc4 = (f32x4){0.f, 0.f, 0.f, 0.f};
#pragma unroll
              for (int q = 0; q < 4; ++q) { const u32x2 w = ((const u32x2*)(PB + (size_t)q * 2048 * 1024 + o_))[c4]; acc4 += (f32x4){bf_lo(w.x), bf_hi(w.x), bf_lo(w.y), bf_hi(w.y)}; }
              y[j] = acc4; }
            s += (y[j][0] * y[j][0] + y[j][1] * y[j][1]) + (y[j][2] * y[j][2] + y[j][3] * y[j][3]); }
        const float rinv = 1.f / sqrtf(wave_sum(s) * (1.f / DM) + EPS);
        const float* gate = p.mod_a + (size_t)8 * 9216 + p.gate_idx * 1024; const float* shift = p.mod_n + (size_t)8 * 9216 + p.shift_idx * 1024; const float* scale = shift + 1024;
        float s2 = 0.f;
#pragma unroll
        for (int j = 0; j < 4; ++j) { const int c4 = lane + 64 * j; const f32x4 gp = ((const f32x4*)p.g_post)[c4], gt = ((const f32x4*)gate)[c4];
            v[j] += y[j] * (gp * gt * (p.weight * rinv)); { u32x2 xo; xo.x = pkh(v[j][0], v[j][1]); xo.y = pkh(v[j][2], v[j][3]); ((u32x2*)((bf16*)p.dst_ctx + o_))[c4] = xo; v[j] = (f32x4){h_lo(xo.x), h_hi(xo.x), h_lo(xo.y), h_hi(xo.y)}; }
            s2 += (v[j][0] * v[j][0] + v[j][1] * v[j][1]) + (v[j][2] * v[j][2] + v[j][3] * v[j][3]); }
        if (p.next) { const float r2 = 1.f / sqrtf(wave_sum(s2) * (1.f / DM) + EPS);
#pragma unroll
            for (int j = 0; j < 4; ++j) { const int c4 = lane + 64 * j; const f32x4 gq = ((const f32x4*)p.g_pre)[c4], sc = ((const f32x4*)scale)[c4], sh = ((const f32x4*)shift)[c4];
                const f32x4 hv = v[j] * r2 * gq * (sc + 1.f) + sh;
                u32x2 o; o.x = pk2(hv[0], hv[1]); o.y = pk2(hv[2], hv[3]); ((u32x2*)(p.H + (size_t)row * DM))[c4] = o; } }
    }
}

__device__ __forceinline__ void ld16(const bf16* p, float* f) {
    const u32x4 a = ((const u32x4*)p)[0], b = ((const u32x4*)p)[1];
    f[0] = bf_lo(a.x); f[1] = bf_hi(a.x); f[2] = bf_lo(a.y); f[3] = bf_hi(a.y); f[4] = bf_lo(a.z); f[5] = bf_hi(a.z); f[6] = bf_lo(a.w); f[7] = bf_hi(a.w);
    f[8] = bf_lo(b.x); f[9] = bf_hi(b.x); f[10] = bf_lo(b.y); f[11] = bf_hi(b.y); f[12] = bf_lo(b.z); f[13] = bf_hi(b.z); f[14] = bf_lo(b.w); f[15] = bf_hi(b.w);
}
__device__ __forceinline__ void st16(bf16* p, const float* f) {
    u32x4 a, b; a.x = pk2(f[0], f[1]); a.y = pk2(f[2], f[3]); a.z = pk2(f[4], f[5]); a.w = pk2(f[6], f[7]);
    b.x = pk2(f[8], f[9]); b.y = pk2(f[10], f[11]); b.z = pk2(f[12], f[13]); b.w = pk2(f[14], f[15]);
    ((u32x4*)p)[0] = a; ((u32x4*)p)[1] = b;
}
__device__ __forceinline__ void da_finish(const bf16* OM, bf16* H, const float* subln, const float* lamp, int rows, int gw, int NGW, int lane) {
    const float lam = lamp[0], oml = lamp[1]; const int d0 = (lane & 7) * 16;
    float g[16];
#pragma unroll
    for (int e = 0; e < 16; ++e) g[e] = subln[d0 + e] * oml;
    for (int row = gw; row < rows; row += NGW) {
        const bf16* p1 = OM + (size_t)row * 2048 + (lane >> 3) * 256 + d0;
        float a[16], b[16]; ld16(p1, a); ld16(p1 + 128, b);
        float s = 0.f;
#pragma unroll
        for (int e = 0; e < 16; ++e) { a[e] = a[e] - lam * b[e]; s += a[e] * a[e]; }
        s = sum8(s); const float rinv = 1.f / sqrtf(s * (1.f / 128.f) + EPS);
#pragma unroll
        for (int e = 0; e < 16; ++e) a[e] = a[e] * rinv * g[e];
        st16(H + (size_t)row * DM + lane * 16, a);
    }
}
__device__ __forceinline__ void hg_finish(bf16* OFH, const bf16* OB, const bf16* P, const float* hgn, int rows, int gw, int NGW, int lane) {
    const int d0 = (lane & 7) * 16; float g[16];
#pragma unroll
    for (int e = 0; e < 16; ++e) g[e] = hgn[d0 + e];
    for (int row = gw; row < rows; row += NGW) {
        float a[16], b[16], gt[16]; ld16(OFH + (size_t)row * DM + lane * 16, a); ld16(OB + (size_t)row * DM + lane * 16, b); ld16(P + (size_t)row * 5120 + 4096 + lane * 16, gt);
        float s = 0.f;
#pragma unroll
        for (int e = 0; e < 16; ++e) { a[e] += b[e]; s += a[e] * a[e]; }
        s = sum8(s); const float rinv = 1.f / sqrtf(s * (1.f / 128.f) + EPS);
#pragma unroll
        for (int e = 0; e < 16; ++e) a[e] = a[e] * rinv * g[e] * gt[e];
        st16(OFH + (size_t)row * DM + lane * 16, a);
    }
}
__device__ __forceinline__ void gqa_fix(bf16* QKV, const float* ss, const float* qn, const float* kn, const float* rope, int rows, int gw, int NGW, int lane) {
    const int d0 = (lane & 7) * 16;
    for (int row = gw; row < rows; row += NGW) {
#pragma unroll
        for (int pass = 0; pass < 2; ++pass) {
            if (pass == 1 && lane >= 16) break;
            const int head = pass * 8 + (lane >> 3);
            bf16* p = QKV + (size_t)row * 1536 + pass * 1024 + lane * 16;
            float a[16]; ld16(p, a);
            const f32x4 s4 = *(const f32x4*)(ss + (size_t)row * 40 + head * 4);
            const float rinv = 1.f / sqrtf(((s4[0] + s4[1]) + (s4[2] + s4[3])) * (1.f / 128.f) + EPS);
            const float* gn = (pass ? kn : qn) + d0;
#pragma unroll
            for (int e = 0; e < 16; ++e) a[e] = a[e] * rinv * gn[e];
            if (row < NLAT) { const int t = row & 4095, hiF = (lane & 7) >= 4, pos = hiF ? (t & 63) : (t >> 6), f0 = (lane & 7) * 8 - (hiF ? 32 : 0);
                const float* rp = rope + (size_t)(pos * 32 + f0) * 2;
#pragma unroll
                for (int q = 0; q < 8; ++q) { const float cs = rp[2 * q], sn = rp[2 * q + 1], x1 = a[2 * q], x2 = a[2 * q + 1]; a[2 * q] = x1 * cs - x2 * sn; a[2 * q + 1] = x1 * sn + x2 * cs; } }
            st16(p, a);
        }
    }
}

__device__ __forceinline__ long hg_row(int ci, int t, int dir, int b) {
    if (ci < 4) { int p = ci * 64 + t; if (dir) p = 255 - p; return (long)NLAT + b * 256 + p; }
    int p = (ci - 4) * 64 + t; if (dir) p = 4095 - p; return (long)b * 4096 + p;
}
__device__ __forceinline__ void stf8(float* d, bf16x8 v) {
    const u32x4 w = __builtin_bit_cast(u32x4, v);
    ((f32x4*)d)[0] = (f32x4){bf_lo(w.x), bf_hi(w.x), bf_lo(w.y), bf_hi(w.y)}; ((f32x4*)d)[1] = (f32x4){bf_lo(w.z), bf_hi(w.z), bf_lo(w.w), bf_hi(w.w)};
}
typedef float f32x4s __attribute__((ext_vector_type(4)));
__device__ __forceinline__ unsigned short bfr(float x) { return (unsigned short)pk2(x, x); }
__device__ __forceinline__ void hg_scan(const bf16* P, bf16* OF, bf16* OB, unsigned char* lds, int G_, int bx, int tid) {
    constexpr int PW = 272, PN = 144;
    unsigned char* QG = lds; unsigned char* KG = QG + 64 * PW; unsigned char* QX = KG + 64 * PW; unsigned char* ST = QX + 64 * PW;
    unsigned char* KDT = ST + 64 * PW; unsigned char* VT = KDT + 128 * PN; unsigned char* ATT = VT + 64 * PN;
    float* SEG = (float*)(ATT + 64 * PN); float* EGL = SEG + 512;
    const int lane = tid & 63, w = tid >> 6, fr = lane & 15, fq = lane >> 4;
    const int c = tid & 127, g = tid >> 7;
    const int vs = tid >> 3, vcb = (tid & 7) * 8;
    const int tt = w >> 1, nb2 = (w & 1) * 2;
    float z0 = 0.f; asm volatile("" : "+v"(z0));
    const f32x4s zz4 = (f32x4s){z0, z0, z0, z0};
    for (int u = bx; u < 256; u += G_) {
        const int vh = u & 1, dir = (u >> 1) & 1, h = (u >> 2) & 7, b = u >> 5;
        bf16* Od = dir ? OB : OF;
        const long rstep = dir ? -5120 : 5120;
        f32x4s Sacc[4];
#pragma unroll
        for (int q = 0; q < 4; ++q) Sacc[q] = zz4;
        for (int idx = tid; idx < 64 * PW / 16; idx += 512) ((f32x4s*)ST)[idx] = zz4;
        unsigned rq[16], rk[16], nq[16], nk[16]; bf16x8 rv, nv;
#define HLOADC(Q, K, V, ci) do { const bf16* _p = P + hg_row(ci, 16 * g, dir, b) * 5120 + h * 128 + c; \
        _Pragma("unroll") for (int i = 0; i < 16; ++i) { Q[i] = _p[i * rstep]; K[i] = _p[i * rstep + 1024 + dir * 1024]; } \
        V = *(const bf16x8*)(P + hg_row(ci, vs, dir, b) * 5120 + 3072 + h * 128 + vh * 64 + vcb); } while (0)
        HLOADC(rq, rk, rv, 0);
        nv = rv;
#pragma unroll
        for (int i = 0; i < 16; ++i) { nq[i] = rq[i]; nk[i] = rk[i]; }
        for (int ci = 0; ci < 68; ++ci) {
            float lfp[16], kf[16], qf[16]; float run = 0.f;
#pragma unroll
            for (int i = 0; i < 16; ++i) { kf[i] = __builtin_bit_cast(float, rk[i] << 16); qf[i] = __builtin_bit_cast(float, rq[i] << 16);
                run += __logf(fmaxf(1.f - kf[i], 1e-30f)); lfp[i] = run; }
            SEG[g * 128 + c] = run;
#pragma unroll
            for (int e = 0; e < 8; ++e) *(unsigned short*)(VT + (vcb + e) * PN + vs * 2) = (unsigned short)rv[e];
            __syncthreads();
            if (ci + 1 < 68) HLOADC(nq, nk, nv, ci + 1);
            { const float s0 = SEG[c], s1 = SEG[128 + c], s2 = SEG[256 + c], s3 = SEG[384 + c];
              const float off = g == 0 ? 0.f : (g == 1 ? s0 : (g == 2 ? s0 + s1 : s0 + s1 + s2)), Gm = s0 + s1, Gl = (s0 + s1) + (s2 + s3);
              const float eGm = __expf(Gm), eLm = __expf(Gl - Gm);
              float kd[16];
#pragma unroll
              for (int i = 0; i < 16; ++i) { float d = off + lfp[i] - Gm; d = fminf(fmaxf(d, -80.f), 80.f);
                  const float e1 = __expf(d), e2 = __builtin_amdgcn_rcpf(e1);
                  const float qg = qf[i] * e1, kg = kf[i] * e2; kd[i] = kg * eLm;
                  const int o = (16 * g + i) * PW + 2 * c;
                  *(unsigned short*)(QG + o) = bfr(qg); *(unsigned short*)(KG + o) = bfr(kg); *(unsigned short*)(QX + o) = bfr(qg * eGm); }
              u32x4 k0, k1;
              k0.x = pk2(kd[0], kd[1]); k0.y = pk2(kd[2], kd[3]); k0.z = pk2(kd[4], kd[5]); k0.w = pk2(kd[6], kd[7]);
              k1.x = pk2(kd[8], kd[9]); k1.y = pk2(kd[10], kd[11]); k1.z = pk2(kd[12], kd[13]); k1.w = pk2(kd[14], kd[15]);
              *(u32x4*)(KDT + c * PN + 32 * g) = k0; *(u32x4*)(KDT + c * PN + 32 * g + 16) = k1;
              if (g == 0) EGL[c] = __expf(Gl); }
            __syncthreads();
            f32x4s oacc[2], aacc[2];
#pragma unroll
            for (int n = 0; n < 2; ++n) { oacc[n] = zz4; aacc[n] = zz4; }
#pragma unroll
            for (int kk = 0; kk < 4; ++kk) { const int ko = (32 * kk + 8 * fq) * 2;
                const bf16x8 a = *(const bf16x8*)(QG + (16 * tt + fr) * PW + ko), ax = *(const bf16x8*)(QX + (16 * tt + fr) * PW + ko);
#pragma unroll
                for (int n = 0; n < 2; ++n) { const bf16x8 bk = *(const bf16x8*)(KG + (16 * (nb2 + n) + fr) * PW + ko), bs = *(const bf16x8*)(ST + (16 * (nb2 + n) + fr) * PW + ko);
                    aacc[n] = __builtin_amdgcn_mfma_f32_16x16x32_bf16(a, bk, aacc[n], 0, 0, 0);
                    oacc[n] = __builtin_amdgcn_mfma_f32_16x16x32_bf16(ax, bs, oacc[n], 0, 0, 0); } }
#pragma unroll
            for (int n = 0; n < 2; ++n)
#pragma unroll
                for (int j = 0; j < 4; ++j) { const int t = 16 * tt + 4 * fq + j, s = 16 * (nb2 + n) + fr; const float val = (s <= t) ? aacc[n][j] : 0.f;
                    *(unsigned short*)(ATT + t * PN + s * 2) = bfr(val); }
            __syncthreads();
#pragma unroll
            for (int kk = 0; kk < 2; ++kk) { const int ko = (32 * kk + 8 * fq) * 2;
                const bf16x8 a = *(const bf16x8*)(ATT + (16 * tt + fr) * PN + ko);
#pragma unroll
                for (int n = 0; n < 2; ++n) { const bf16x8 bv = *(const bf16x8*)(VT + (16 * (nb2 + n) + fr) * PN + ko);
                    oacc[n] = __builtin_amdgcn_mfma_f32_16x16x32_bf16(a, bv, oacc[n], 0, 0, 0); } }
#pragma unroll
            for (int j = 0; j < 4; ++j) { const long r = hg_row(ci, 16 * tt + 4 * fq + j, dir, b);
#pragma unroll
                for (int n = 0; n < 2; ++n) Od[r * DM + h * 128 + vh * 64 + 16 * (nb2 + n) + fr] = bfr(oacc[n][j]); }
            { const f32x4s eg = *(const f32x4s*)(EGL + 16 * w + 4 * fq);
#pragma unroll
              for (int q = 0; q < 4; ++q) Sacc[q] = Sacc[q] * eg;
#pragma unroll
              for (int kk = 0; kk < 2; ++kk) { const int ko = (32 * kk + 8 * fq) * 2;
                  const bf16x8 a = *(const bf16x8*)(KDT + (16 * w + fr) * PN + ko);
#pragma unroll
                  for (int q = 0; q < 4; ++q) { const bf16x8 bv = *(const bf16x8*)(VT + (16 * q + fr) * PN + ko);
                      Sacc[q] = __builtin_amdgcn_mfma_f32_16x16x32_bf16(a, bv, Sacc[q], 0, 0, 0); } }
#pragma unroll
              for (int q = 0; q < 4; ++q) { u32x2 o2; o2.x = pk2(Sacc[q][0], Sacc[q][1]); o2.y = pk2(Sacc[q][2], Sacc[q][3]);
                  *(u32x2*)(ST + (16 * q + fr) * PW + (16 * w + 4 * fq) * 2) = o2; } }
            __syncthreads();
#pragma unroll
            for (int i = 0; i < 16; ++i) { rq[i] = nq[i]; rk[i] = nk[i]; }
            rv = nv;
        }
#undef HLOADC
    }
}

#define XB_TMO      128
#define XB_XCNT(j)  (256  + 64 * (j))
#define XB_XSUB(j)  (1280 + 64 * (j))
#define XB_XGEN(j)  (2304 + 64 * (j))
#define XB_TOP      3328
#define XB_TOPGEN   3392
#define XCD_BAR_WORDS 3456
#define XB_SPIN_CAP (1u << 18)

__device__ __forceinline__ unsigned xb_ld(unsigned* p)              { return __hip_atomic_load(p, __ATOMIC_RELAXED, __HIP_MEMORY_SCOPE_AGENT); }
__device__ __forceinline__ unsigned xb_add(unsigned* p, unsigned v) { return __hip_atomic_fetch_add(p, v, __ATOMIC_RELAXED, __HIP_MEMORY_SCOPE_AGENT); }
__device__ __forceinline__ unsigned xb_xcc_id() { return (unsigned)__builtin_amdgcn_s_getreg((3 << 11) | 20) & 0xFu; }
#define XB_SPIN(cond, bar) do { unsigned _sp = 0; while (cond) { __builtin_amdgcn_s_sleep(1); \
    if ((++_sp & 255u) == 0u) { if (xb_ld(&(bar)[XB_TMO])) break; if (_sp > XB_SPIN_CAP) { atomicAdd(&(bar)[XB_TMO], 1u); break; } } } } while (0)

struct XcdBarrier {
    unsigned* bar; unsigned x;
    volatile LAS unsigned* st;
};

__device__ __forceinline__ XcdBarrier xcd_barrier_post(unsigned* bar, volatile LAS unsigned* st, int tid) {
    XcdBarrier b; b.bar = bar; b.x = xb_xcc_id(); b.st = st;
    if (tid == 0) (void)xb_add(&bar[XB_XCNT(b.x)], 1u);
    return b;
}
__device__ __forceinline__ void xcd_barrier_complete(unsigned* bar, unsigned x, unsigned& nloc, unsigned& nx) {
    const unsigned G = gridDim.x * gridDim.y * gridDim.z;
    unsigned sum, cnt, mine, sp = 0u;
    for (;;) {
        sum = 0u; cnt = 0u; mine = 0u;
#pragma unroll
        for (unsigned j = 0; j < 16; ++j) { const unsigned c = xb_ld(&bar[XB_XCNT(j)]); sum += c; cnt += (c > 0u) ? 1u : 0u; mine = (j == x) ? c : mine; }
        if (sum == G) break;
        __builtin_amdgcn_s_sleep(1);
        if ((++sp & 255u) == 0u) { if (xb_ld(&bar[XB_TMO])) break; if (sp > XB_SPIN_CAP) { atomicAdd(&bar[XB_TMO], 1u); break; } }
    }
    nloc = mine > 0u ? mine : 1u; nx = cnt > 0u ? cnt : 1u;
}

__device__ __forceinline__ void xcd_barrier(const XcdBarrier& b, int tid) {
    asm volatile("s_waitcnt vmcnt(0)" ::: "memory");
    __syncthreads();
    if (tid == 0) {
        unsigned* bar = b.bar;
        __builtin_amdgcn_s_waitcnt(0);
        unsigned nloc = b.st[0], nx = b.st[1];
        if (nloc == 0u) { xcd_barrier_complete(bar, b.x, nloc, nx); b.st[0] = nloc; b.st[1] = nx; }
        const unsigned old = xb_add(&bar[XB_XSUB(b.x)], 1u);
        const unsigned gen = old / nloc;
        if (old + 1u == (gen + 1u) * nloc) {
            __builtin_amdgcn_fence(__ATOMIC_RELEASE, "agent");
            asm volatile("s_waitcnt vmcnt(0)" ::: "memory");
            const unsigned og = xb_add(&bar[XB_TOP], 1u);
            const unsigned tg = og / nx;
            if (og + 1u == (tg + 1u) * nx) xb_add(&bar[XB_TOPGEN], 1u);
            else XB_SPIN(xb_ld(&bar[XB_TOPGEN]) == tg, bar);
            __builtin_amdgcn_fence(__ATOMIC_ACQUIRE, "agent");
            xb_add(&bar[XB_XGEN(b.x)], 1u);
            asm volatile("s_waitcnt vmcnt(0)" ::: "memory");
        } else {
            XB_SPIN(xb_ld(&bar[XB_XGEN(b.x)]) == gen, bar);
            __builtin_amdgcn_fence(__ATOMIC_ACQUIRE, "agent");
            asm volatile("s_waitcnt vmcnt(0)" ::: "memory");
        }
    }
    __syncthreads();
}

struct OneUnit { int pm, pn;
    __device__ __forceinline__ bool next(int i, pg8::Unit& u) const { u.pm = pm; u.pn = pn; return i == 0; }
    __device__ __forceinline__ void a_ready(const pg8::Unit&) const {}
    __device__ __forceinline__ void done(const pg8::Unit&) const {}
};
__device__ __forceinline__ void panel_barrier(unsigned* cnt, unsigned n, int tid) {
    asm volatile("s_waitcnt vmcnt(0)" ::: "memory"); __syncthreads();
    if (tid == 0) {
        __builtin_amdgcn_fence(__ATOMIC_RELEASE, "agent"); asm volatile("s_waitcnt vmcnt(0)" ::: "memory");
        (void)xb_add(cnt, 1u);
        unsigned sp = 0u; while (xb_ld(cnt) < n) { __builtin_amdgcn_s_sleep(1); if (++sp > (1u << 20)) break; }
        __builtin_amdgcn_fence(__ATOMIC_ACQUIRE, "agent"); asm volatile("s_waitcnt vmcnt(0)" ::: "memory");
    }
    __syncthreads();
}
constexpr size_t WS_BAR = 1792 * 1024;
__global__ void __launch_bounds__(512, 2) mk_fwd(Args args) {
    extern __shared__ __attribute__((aligned(16))) unsigned char lds[];
    cg::grid_group grid = cg::this_grid();
    const int G = gridDim.x, bx = blockIdx.x, NGW = G * 8;
#define TID_INIT const int tid = my_tid(wave_s); const int lane = tid & 63, wave = __builtin_amdgcn_readfirstlane(tid >> 6), gw = bx * 8 + wave; (void)lane; (void)gw;
    typedef const __attribute__((address_space(4))) unsigned char* kptr_t;
#define KIN(i) (*(const float* const __attribute__((address_space(4)))*)(kp + 8 * (i)))
#define PH_PTRS kptr_t kp = (kptr_t)__builtin_amdgcn_kernarg_segment_ptr(); asm volatile("" : "+s"(kp)); \
    unsigned char* ws = *(unsigned char* const __attribute__((address_space(4)))*)(kp + 176); float* const outp = *(float* const __attribute__((address_space(4)))*)(kp + 168); (void)outp; \
    float* MOD = (float*)(ws + WS_MOD); float* LB = (float*)(ws + WS_LB); float* ROPE_DA = (float*)(ws + WS_ROPE_DA); float* ROPE_GQ = (float*)(ws + WS_ROPE_GQ); \
    float* LAM = (float*)(ws + WS_LAM); float* SS = (float*)(ws + WS_SS); float* XC = (float*)(ws + WS_XC); \
    bf16* WB = (bf16*)(ws + WS_W); bf16* H = (bf16*)(ws + WS_H); bf16* Y = (bf16*)(ws + WS_Y); bf16* U = (bf16*)(ws + WS_U); bf16* OM = U + (size_t)NTOK * 3072; const float* norm_g = KIN(6); \
    (void)MOD; (void)LB; (void)ROPE_DA; (void)ROPE_GQ; (void)LAM; (void)SS; (void)XC; (void)WB; (void)H; (void)Y; (void)U; (void)OM; (void)norm_g;
    PG8_LAS unsigned char* ring = (PG8_LAS unsigned char*)lds;
    const int lo = args.ph_lo, hi = args.ph_hi; int pc = 0;
#define PH_ON (pc >= lo && pc < hi)
    volatile LAS unsigned* bst = (volatile LAS unsigned*)(ring + 140288);
    const int wave_s = __builtin_amdgcn_readfirstlane((int)threadIdx.x >> 6);
    if ((int)threadIdx.x == 0) { bst[0] = 0u; bst[1] = 0u; }
    __syncthreads();
    XcdBarrier xbar; xbar.bar = (unsigned*)(args.ws + WS_BAR); xbar.x = 0; xbar.st = bst;
    if (hi - lo > 1) xbar = xcd_barrier_post((unsigned*)(args.ws + WS_BAR), bst, (int)threadIdx.x);
#define PH_END do { if (pc >= lo && pc + 1 < hi) xcd_barrier(xbar, my_tid(wave_s)); ++pc; } while (0)

    if (PH_ON) { PH_PTRS
        TID_INIT
        float* sc = (float*)lds; float* red = sc + 9 * 1024;
        for (int idx = tid; idx < 9 * 1024; idx += 512) { const int r = idx >> 10, k = idx & 1023; const float v = r < 8 ? KIN(1)[r * 1024 + k] : KIN(3)[k]; sc[idx] = v / (1.f + expf(-v)); }
        __syncthreads();
        for (int ch = bx; ch < 576; ch += G) { const int layer = ch / 144, n0 = (ch % 144) * 64, c4 = tid & 15, ks = tid >> 4;
            const float* wp = KIN(4) + ((size_t)layer * 1024 + ks * 32) * 9216 + n0 + 4 * c4; const float* sk = sc + ks * 32;
            f32x4 acc[9];
#pragma unroll
            for (int r = 0; r < 9; ++r) acc[r] = (f32x4){0.f, 0.f, 0.f, 0.f};
#pragma unroll 8
            for (int k = 0; k < 32; ++k) { const f32x4 wv = *(const f32x4*)(wp + (size_t)k * 9216);
#pragma unroll
                for (int r = 0; r < 9; ++r) acc[r] += wv * sk[r * 1024 + k]; }
#pragma unroll
            for (int r = 0; r < 9; ++r) *(f32x4*)(red + (ks * 9 + r) * 64 + 4 * c4) = acc[r];
            __syncthreads();
            for (int o = tid; o < 576; o += 512) { const int r = o >> 6, cc = o & 63; float s = KIN(5)[layer * 9216 + n0 + cc];
#pragma unroll 8
                for (int k2 = 0; k2 < 32; ++k2) s += red[(k2 * 9 + r) * 64 + cc];
                MOD[(size_t)(layer * 9 + r) * 9216 + n0 + cc] = s; }
            __syncthreads();
        }
        if (bx == G - 1) {
            for (int idx = tid; idx < 2048; idx += 512) { const int dir = idx >> 10, ch = idx & 1023; const float* lp = KIN(14) + (size_t)dir * 4 * 1024 + ch;
                const float v0 = lp[0], v1 = lp[1024], v2 = lp[2048], v3 = lp[3072], m = fmaxf(fmaxf(v0, v1), fmaxf(v2, v3));
                const float e0 = expf(v0 - m), e1 = expf(v1 - m), e2 = expf(v2 - m), e3 = expf(v3 - m); LB[idx] = e1 / (e0 + e1 + e2 + e3); }
            for (int idx = tid; idx < 64 * 16; idx += 512) { const int pos = idx >> 4, f = idx & 15; const float inv = powf(10000.f, -(float)f / 16.f), ang = (float)pos * inv;
                ROPE_DA[2 * idx] = cosf(ang); ROPE_DA[2 * idx + 1] = sinf(ang); }
            for (int idx = tid; idx < 64 * 32; idx += 512) { const int pos = idx >> 5, f = idx & 31; const float inv = powf(10000.f, -(float)f / 32.f), ang = (float)pos * inv;
                ROPE_GQ[2 * idx] = cosf(ang); ROPE_GQ[2 * idx + 1] = sinf(ang); }
            if (tid < 2) { const float* lp = KIN(10) + tid * 256; float s1 = 0.f, s2 = 0.f;
                for (int d = 0; d < 64; ++d) { s1 += lp[d] * lp[64 + d]; s2 += lp[128 + d] * lp[192 + d]; }
                const float li = 0.8f - 0.6f * expf(-0.3f * (float)(3 * tid)); LAM[2 * tid] = expf(s1) - expf(s2) + li; LAM[2 * tid + 1] = 1.f - li; }
        }
        __syncthreads();
        float* scr = (float*)(lds + wave * 16384);
        constexpr int NITEMS = 42240;
#define CONV_DECODE(IT, SRC, DST, KK, NN, MODE, RR) do { int r = (IT); MODE = 0; \
            if (r < 22528) { const int m = r / 2816; r -= m * 2816; SRC = KIN(7) + (size_t)m * 1024 * 5632; DST = WB + W_FIN + (size_t)m * 5632 * 1024; KK = 1024; NN = 5632; MODE = 1; } \
            else if ((r -= 22528) < 11264) { const int m = r / 1408; r -= m * 1408; SRC = KIN(8) + (size_t)m * 2816 * 1024; DST = WB + W_FOUT + (size_t)m * 1024 * 2816; KK = 2816; NN = 1024; } \
            else if ((r -= 11264) < 3072) { const int m = r / 1536; r -= m * 1536; SRC = KIN(9) + (size_t)m * 1024 * 3072; DST = WB + W_DAQ + (size_t)m * 3072 * 1024; KK = 1024; NN = 3072; } \
            else if ((r -= 3072) < 1024) { const int m = r / 512; r -= m * 512; SRC = KIN(12) + (size_t)m * 1024 * 1024; DST = WB + W_DAO + (size_t)m * 1024 * 1024; KK = 1024; NN = 1024; } \
            else if ((r -= 1024) < 2560) { SRC = KIN(13); DST = WB + W_HGI; KK = 1024; NN = 5120; } \
            else if ((r -= 2560) < 512) { SRC = KIN(16); DST = WB + W_HGO; KK = 1024; NN = 1024; } \
            else if ((r -= 512) < 768) { SRC = KIN(17); DST = WB + W_GQQ; KK = 1024; NN = 1536; } \
            else { r -= 768; SRC = KIN(20); DST = WB + W_GQO; KK = 1024; NN = 1024; } RR = r; } while (0)
#define CONV_LOAD(T, SRC, NN, RR) do { const int nblk = (NN) / 32, kb = (RR) / nblk, nb = (RR) % nblk; \
            _Pragma("unroll") for (int i = 0; i < 8; ++i) T[i] = *(const f32x4*)((SRC) + (size_t)(64 * kb + (lane >> 3) + 8 * i) * (NN) + 32 * nb + (lane & 7) * 4); } while (0)
        { int it = gw; const float* src = nullptr; bf16* dst = nullptr; int K = 0, N = 0, mode = 0, rr = 0; f32x4 t[8], tn[8];
          if (it < NITEMS) { CONV_DECODE(it, src, dst, K, N, mode, rr); CONV_LOAD(t, src, N, rr); }
          while (it < NITEMS) {
            const int nit = it + NGW; const float* nsrc = nullptr; bf16* ndst = nullptr; int nK = 0, nN = 0, nmode = 0, nrr = 0;
            if (nit < NITEMS) { CONV_DECODE(nit, nsrc, ndst, nK, nN, nmode, nrr); CONV_LOAD(tn, nsrc, nN, nrr); }
            { const int nblk = N / 32, kb = rr / nblk, nb = rr % nblk, k0 = 64 * kb, n0 = 32 * nb; int drow0 = n0;
              if (mode == 1) { const int up = n0 >= DFF, j0 = up ? n0 - DFF : n0; drow0 = (j0 >> 7) * 256 + (j0 & 127) + (up ? 128 : 0); }
              const int kr8 = lane >> 3, n4 = (lane & 7) * 4;
#pragma unroll
              for (int i = 0; i < 8; ++i) { float* d = scr + (kr8 + 8 * i) * 33 + n4; d[0] = t[i][0]; d[1] = t[i][1]; d[2] = t[i][2]; d[3] = t[i][3]; }
              asm volatile("s_waitcnt lgkmcnt(0)" ::: "memory");
              const int c = lane & 7;
#pragma unroll
              for (int j = 0; j < 4; ++j) { const int n = (lane >> 3) + 8 * j; const float* s = scr + (8 * c) * 33 + n;
                  u32x4 o; o.x = pk2(s[0 * 33], s[1 * 33]); o.y = pk2(s[2 * 33], s[3 * 33]); o.z = pk2(s[4 * 33], s[5 * 33]); o.w = pk2(s[6 * 33], s[7 * 33]);
                  *(u32x4*)(dst + (size_t)(drow0 + n) * K + k0 + 8 * c) = o; }
              asm volatile("s_waitcnt lgkmcnt(0)" ::: "memory"); }
            it = nit; src = nsrc; dst = ndst; K = nK; N = nN; mode = nmode; rr = nrr;
#pragma unroll
            for (int i = 0; i < 8; ++i) t[i] = tn[i];
          } }
#undef CONV_DECODE
#undef CONV_LOAD
    }
    if (lo == 0 && hi > 1) grid.sync();
    ++pc;

    size_t AoutO = 0, WoutO = 0; int Kout = 0;
    for (int t = 0; t <= 12; ++t) {
        const int i = t / 3, sub = t - 3 * i, kind = i % 3, jl = i / 3;
        const int rows = (t >= 11) ? NLAT : NTOK;
        if (PH_ON) { PH_PTRS
            RowP p;
            const bool first = (t <= 1);
            bf16* XT = U + (size_t)200 * 1024 * 1024 / 2;
            p.src_f32 = first; p.dst_f32 = (t == 12);
            p.src_lat = first ? (const void*)KIN(0) : (t == 12 ? (const void*)XT : (const void*)outp); p.src_ctx = first ? (const void*)KIN(2) : (const void*)XC;
            p.dst_lat = (t == 11) ? (void*)XT : (void*)outp; p.dst_ctx = XC; p.rows = rows;
            p.apply = t > 0; p.Y = Y; p.ss = SS;
            { const int tp = t > 0 ? t - 1 : 0, ip = tp / 3, sp = tp - 3 * ip; p.g_post = norm_g + (size_t)(ip * 6 + 2 * sp + 1) * 1024; p.mod_a = MOD + (size_t)ip * 9 * 9216; p.gate_idx = 3 * sp + 2; p.weight = sp == 1 ? 1.f : 0.5f; }
            p.next = t < 12; { const int ii = t < 12 ? i : 3, s2 = t < 12 ? sub : 2; p.g_pre = norm_g + (size_t)(ii * 6 + 2 * s2) * 1024; p.mod_n = MOD + (size_t)ii * 9 * 9216; p.shift_idx = 3 * s2; }
            p.H = H;
            const int nb = (t >= 1 && t <= 10) ? 64 : 0;
            bf16* PP = U + (size_t)200 * 1024 * 1024 / 2;
            if (bx < nb) {
                const int tile = bx >> 1, half = bx & 1, Kh = Kout >> 1;
                pg8::Gemm g{(const bf16*)(ws + AoutO) + half * Kh, (const bf16*)(ws + WoutO) + half * Kh, NTOK, 1024, Kh, Kout}; OneUnit S1{128 + (tile >> 2), tile & 3};
                pg8::EpiPart E{PP + (size_t)half * 2 * 2048 * 1024};
                pg8::gemm_phase<pg8::EpiPart, OneUnit, true, true>(ring, g, S1, E, wave_s);
                panel_barrier((unsigned*)(ws + WS_BAR + 16384) + ((t - 1) * 8 + (bx >> 3)) * 64, 8u, my_tid(wave_s));
                TID_INIT
                const int r0 = NLAT + 256 * (bx >> 3) + 32 * (bx & 7);
                rowwise_ctx(p, PP, r0, r0 + 32, wave, 8, lane);
            } else {
                TID_INIT
                rowwise(p, 0, nb ? NLAT : rows, (bx - nb) * 8 + wave, (G - nb) * 8, lane);
            }
        }
        PH_END;
        if (t == 12) break;
        const int mrows = (i == 3) ? NLAT : NTOK;

        if (sub != 1) {
            const int fidx = i * 2 + (sub >> 1);
            if (PH_ON) { PH_PTRS
                pg8::Gemm g{H, WB + W_FIN + (size_t)fidx * 5632 * 1024, rows, 5632, 1024}; pg8::StaticOrder S; S.init(rows, 5632, G, bx);
                pg8::EpiSwiglu E{U, DFF};
                pg8::gemm_phase<pg8::EpiSwiglu, pg8::StaticOrder, true, true>(ring, g, S, E, wave_s);
            }
            PH_END;
            AoutO = WS_U; WoutO = WS_W + 2 * (W_FOUT + (size_t)fidx * 1024 * 2816); Kout = DFF;
        } else if (kind == 0) {
            const bool need_ctx = i < 3;
            if (PH_ON) { PH_PTRS
                pg8::Gemm g{H, WB + W_DAQ + (size_t)jl * 3072 * 1024, NTOK, 3072, 1024}; pg8::StaticOrder S; S.init(NTOK, 3072, G, bx);
                pg8::EpiDaQkv E{U, ROPE_DA};
                pg8::gemm_phase<pg8::EpiDaQkv, pg8::StaticOrder, true, true>(ring, g, S, E, wave_s);
            }
            PH_END;
            if (PH_ON) { PH_PTRS
                const int nlat = 1024, ntot = nlat + (need_ctx ? 64 : 0);
                float* stash = (float*)OM + (size_t)bx * 32768;
                const float lam = LAM[2 * jl], oml = LAM[2 * jl + 1]; const float* subln = KIN(11) + jl * 128;
                for (int it = 0;; ++it) { const int u = it * G + bx; if (u >= ntot) break;
                    const bf16 *q0, *k1, *v1, *k2, *v2; bf16* ob; int n1, seq;
                    if (u < nlat) { int pair, qb; if (G == 256) { pair = it * 16 + (bx & 7) * 2 + (bx >> 7); qb = (bx >> 3) & 15; } else { pair = u >> 4; qb = u & 15; }
                        const int b = pair >> 3, h = pair & 7;
                        const bf16* base = U + (size_t)(b * 4096) * 3072 + h * 128; const bf16* cb = U + (size_t)(NLAT + b * 256) * 3072 + h * 128;
                        q0 = base + (size_t)(qb * 256) * 3072; k1 = base + 1024; v1 = base + 2048; k2 = cb + 1024; v2 = cb + 2048; n1 = 4096; seq = 4352;
                        ob = H + (size_t)(b * 4096 + qb * 256) * 1024 + h * 128;
                    } else { const int v = u - nlat, b = v >> 3, h = v & 7;
                        const bf16* cb = U + (size_t)(NLAT + b * 256) * 3072 + h * 128;
                        q0 = cb; k1 = cb + 1024; v1 = cb + 2048; k2 = k1; v2 = v1; n1 = 0; seq = 256;
                        ob = H + (size_t)(NLAT + b * 256) * 1024 + h * 128; }
                    att::attn_unit<64, 3072, 3072, 1024, 1>(q0, k1, v1, n1, k2, v2, seq, 0, ob, (char*)lds, wave_s, stash, lam, oml, subln);
                    att::attn_unit<64, 3072, 3072, 1024, 2>(q0 + 64, k1, v1, n1, k2, v2, seq, 128, ob, (char*)lds, wave_s, stash, lam, oml, subln);
                }
                __syncthreads();
            }
            PH_END;
            AoutO = WS_H; WoutO = WS_W + 2 * (W_DAO + (size_t)jl * 1024 * 1024); Kout = 1024;
        } else if (kind == 1) {
            if (PH_ON) { PH_PTRS
                pg8::Gemm g{H, WB + W_HGI, NTOK, 5120, 1024}; pg8::StaticOrder S; S.init(NTOK, 5120, G, bx);
                pg8::EpiHg E{U, LB};
                pg8::gemm_phase<pg8::EpiHg, pg8::StaticOrder, true, true>(ring, g, S, E, wave_s);
            }
            PH_END;
            if (PH_ON) { PH_PTRS TID_INIT hg_scan(U, H, Y, lds, G, bx, tid); }
            PH_END;
            if (PH_ON) { PH_PTRS TID_INIT hg_finish(H, Y, U, KIN(15) + jl * 128, mrows, gw, NGW, lane); }
            PH_END;
            AoutO = WS_H; WoutO = WS_W + 2 * W_HGO; Kout = 1024;
        } else {
            const bool need_ctx = i < 3;
            if (PH_ON) { PH_PTRS
                pg8::Gemm g{H, WB + W_GQQ, NTOK, 1536, 1024}; pg8::StaticOrder S; S.init(NTOK, 1536, G, bx);
                pg8::EpiGqaQkv E{U, SS};
                pg8::gemm_phase<pg8::EpiGqaQkv, pg8::StaticOrder, true, true>(ring, g, S, E, wave_s);
            }
            PH_END;
            if (PH_ON) { PH_PTRS TID_INIT gqa_fix(U, SS, KIN(18) + jl * 128, KIN(19) + jl * 128, ROPE_GQ, NTOK, gw, NGW, lane); }
            PH_END;
            if (PH_ON) { PH_PTRS
                const int nlat = 1024, ntot = nlat + (need_ctx ? 64 : 0);
                for (int it = 0;; ++it) { const int u = it * G + bx; if (u >= ntot) break;
                    if (u < nlat) { int pair, sb; if (G == 256) { pair = (it >> 1) * 8 + (bx & 7); sb = (it & 1) * 32 + (bx >> 3); } else { pair = u >> 6; sb = u & 63; }
                        const int b = pair >> 1, kvh = pair & 1, head = kvh * 4 + (sb >> 4), qb = sb & 15;
                        const bf16* base = U + (size_t)(b * 4096) * 1536; const bf16* cb = U + (size_t)(NLAT + b * 256) * 1536;
                        att::attn_unit_2b<128, 1536, 1536, 1024>(base + (size_t)(qb * 256) * 1536 + head * 128, base + 1024 + kvh * 128, base + 1280 + kvh * 128, 4096,
                                                              cb + 1024 + kvh * 128, cb + 1280 + kvh * 128, 4352, 0, H + (size_t)(b * 4096 + qb * 256) * 1024 + head * 128, (char*)lds, wave_s);
                    } else { const int v = u - nlat, b = v >> 3, head = v & 7, kvh = head >> 2;
                        const bf16* cb = U + (size_t)(NLAT + b * 256) * 1536;
                        att::attn_unit_2b<128, 1536, 1536, 1024>(cb + head * 128, cb + 1024 + kvh * 128, cb + 1280 + kvh * 128, 0, cb + 1024 + kvh * 128, cb + 1280 + kvh * 128, 256, 0,
                                                              H + (size_t)(NLAT + b * 256) * 1024 + head * 128, (char*)lds, wave_s); }
                }
                __syncthreads();
            }
            PH_END;
            AoutO = WS_H; WoutO = WS_W + 2 * W_GQO; Kout = 1024;
        }
        if (PH_ON) { PH_PTRS
            pg8::Gemm g{(const bf16*)(ws + AoutO), (const bf16*)(ws + WoutO), NLAT, 1024, Kout}; pg8::StaticOrder S; S.init(NLAT, 1024, G, bx);
            pg8::EpiY E{Y, SS};
            pg8::gemm_phase<pg8::EpiY, pg8::StaticOrder, true, true>(ring, g, S, E, wave_s);
        }
        PH_END;
    }
}

extern "C" void kernel_launch(void* const* d_in, const int* in_sizes, int n_in, void* d_out, int out_size, void* d_ws, size_t ws_size, hipStream_t stream) {
    static int grid = 0, mode = 0;
    if (grid == 0) {
        if (n_in != 21 || out_size != NLAT * DM || ws_size < WS_END) { fprintf(stderr, "kernel_launch: bad shapes n_in %d out %d ws %zu (need %zu)\n", n_in, out_size, ws_size, (size_t)WS_END); grid = -1; return; }
        int dev = 0, cus = 0, per_cu = 0;
        hipGetDevice(&dev); hipDeviceGetAttribute(&cus, hipDeviceAttributeMultiprocessorCount, dev);
        if (hipFuncSetAttribute((const void*)mk_fwd, hipFuncAttributeMaxDynamicSharedMemorySize, LDS_BYTES) != hipSuccess) { fprintf(stderr, "kernel_launch: hipFuncSetAttribute failed\n"); grid = -1; return; }
        if (hipOccupancyMaxActiveBlocksPerMultiprocessor(&per_cu, (const void*)mk_fwd, 512, LDS_BYTES) != hipSuccess || per_cu < 1) { fprintf(stderr, "kernel_launch: occupancy query says %d\n", per_cu); per_cu = 1; }
        (void)hipGetLastError();
        grid = cus * 1; mode = 1;
    }
    if (grid < 0) return;
    if (hipMemsetAsync((char*)d_ws + WS_BAR, 0, 65536, stream) != hipSuccess) { fprintf(stderr, "kernel_launch: memset failed\n"); return; }
    Args a{};
    for (int i = 0; i < 21; ++i) a.in[i] = (const float*)d_in[i];
    a.out = (float*)d_out; a.ws = (unsigned char*)d_ws;
    if (mode == 1) {
        a.ph_lo = 0; a.ph_hi = NPHASE;
        void* kargs[] = {&a};
        hipError_t e = hipLaunchCooperativeKernel((const void*)mk_fwd, dim3(grid), dim3(512), kargs, LDS_BYTES, stream);
        if (e == hipSuccess) return;
        fprintf(stderr, "kernel_launch: cooperative launch failed: %s (grid %d); falling back to one launch per phase\n", hipGetErrorString(e), grid);
        (void)hipGetLastError(); mode = 2;
    }
    for (int p = 0; p < NPHASE; ++p) { a.ph_lo = p; a.ph_hi = p + 1; hipLaunchKernelGGL(mk_fwd, dim3(grid), dim3(512), LDS_BYTES, stream, a); }
}
```

```cpp
#include <hip/hip_runtime.h>
#include <hip/hip_cooperative_groups.h>
#include <cstdio>
#include <cstdint>
namespace cg = cooperative_groups;
__device__ __forceinline__ int my_tid(int wave_s) { unsigned m = ~0u; asm volatile("" : "+s"(m)); return (wave_s << 6) | (int)__builtin_amdgcn_mbcnt_hi(m, __builtin_amdgcn_mbcnt_lo(m, 0u)); }
namespace pg8 {
#define PG8_LAS __attribute__((address_space(3)))
typedef unsigned short bf16_t;
typedef short bf16x8 __attribute__((ext_vector_type(8)));
typedef float f32x4 __attribute__((ext_vector_type(4)));
typedef unsigned u32x4 __attribute__((ext_vector_type(4)));
constexpr int BM = 256, BK = 64, HALF = 128, HTB = HALF * BK * 2  , STAGE_BYTES = 8 * HTB, NXCD = 8, WGM = 8;

__host__ __device__ __forceinline__ int lds_byte(int r, int c) { const int st = (r >> 4) * 2 + (c >> 5), rr = r & 15, cc = c & 31, ob = rr * 64 + cc * 2; return st * 1024 + (ob ^ (((ob >> 9) & 1) << 5)); }
__host__ __device__ __forceinline__ void stage_rc(int b, int& R, int& C) { const int st = b / 1024, sb = b % 1024, swz = sb ^ (((sb >> 9) & 1) << 5); R = (st >> 1) * 16 + swz / 64; C = (st & 1) * 32 + (swz % 64) / 2; }
__host__ __device__ __forceinline__ int perm32(int rho) { const int n = rho >> 4, i = rho & 15; return 8 * (i >> 2) + 4 * n + (i & 3); }

struct Unit { int pm, pn; };
struct Gemm { const bf16_t* A; const bf16_t* Bt; int M, N, K; int ld = 0; };

struct StaticOrder {
    int nM, nN, nwg, G, c;
    __host__ __device__ void init(int M, int N, int G_, int c_) { nM = M / BM; nN = N / BM; nwg = nM * nN; G = G_; c = c_; }
    __host__ __device__ bool next(int i, Unit& u) const {
        const long L = (long)i * G + c; if (L >= nwg) return false;
        int wgid = (int)L; { const int q = nwg / NXCD, r = nwg % NXCD, xcd = wgid % NXCD, off = wgid / NXCD; wgid = (xcd < r ? xcd * (q + 1) : r * (q + 1) + (xcd - r) * q) + off; }
        const int nig = WGM * nN, gid = wgid / nig, fm = gid * WGM, gsz = (nM - fm) < WGM ? (nM - fm) : WGM;
        u.pm = fm + ((wgid % nig) % gsz); u.pn = (wgid % nig) / gsz; return true;
    }
    __device__ __forceinline__ void a_ready(const Unit&) const {}
    __device__ __forceinline__ void done(const Unit&) const {}
};
__device__ __forceinline__ unsigned cvt_pk_bf16(float lo, float hi) { unsigned r; asm volatile("v_cvt_pk_bf16_f32 %0, %1, %2" : "=v"(r) : "v"(lo), "v"(hi)); return r; }
__device__ __forceinline__ float silu_f(float x) { return x * __builtin_amdgcn_rcpf(1.f + __builtin_amdgcn_exp2f(-1.4426950408889634f * x)); }
__device__ __forceinline__ float sigm_f(float x) { return __builtin_amdgcn_rcpf(1.f + __builtin_amdgcn_exp2f(-1.4426950408889634f * x)); }
constexpr int SS_LD = 40;

struct EpiSwiglu { static constexpr bool PERM = true, AFTER_DRAIN = false; bf16_t* O; int ldc;
    __device__ __forceinline__ void operator()(const f32x4 (&acc)[2][2][4][2], const Unit& u, int wr, int wc, int fr, int fq) const {
        const int row0 = u.pm * BM + wr * 64 + fr, col0 = u.pn * HALF + wc * 32 + 8 * fq;
#pragma unroll
        for (int ai = 0; ai < 2; ++ai)
#pragma unroll
            for (int m = 0; m < 4; ++m) { bf16_t* rowp = O + (size_t)(row0 + ai * HALF + m * 16) * ldc + col0;
                const f32x4 g0 = acc[ai][0][m][0], g1 = acc[ai][0][m][1], u0 = acc[ai][1][m][0], u1 = acc[ai][1][m][1];
                u32x4 w; w.x = cvt_pk_bf16(silu_f(g0[0]) * u0[0], silu_f(g0[1]) * u0[1]); w.y = cvt_pk_bf16(silu_f(g0[2]) * u0[2], silu_f(g0[3]) * u0[3]);
                w.z = cvt_pk_bf16(silu_f(g1[0]) * u1[0], silu_f(g1[1]) * u1[1]); w.w = cvt_pk_bf16(silu_f(g1[2]) * u1[2], silu_f(g1[3]) * u1[3]);
                *(u32x4*)rowp = w; }
    }
};
struct EpiY { static constexpr bool PERM = true, AFTER_DRAIN = false; bf16_t* O; float* ss;
    __device__ __forceinline__ void operator()(const f32x4 (&acc)[2][2][4][2], const Unit& u, int wr, int wc, int fr, int fq) const {
        const int row0 = u.pm * BM + wr * 64 + fr, col0 = u.pn * BM + wc * 32 + 8 * fq;
#pragma unroll
        for (int ai = 0; ai < 2; ++ai)
#pragma unroll
            for (int m = 0; m < 4; ++m) { const int row = row0 + ai * HALF + m * 16; bf16_t* rowp = O + (size_t)row * 1024 + col0; float s = 0.f;
#pragma unroll
                for (int bj = 0; bj < 2; ++bj) { const f32x4 v0 = acc[ai][bj][m][0], v1 = acc[ai][bj][m][1];
                    s += (v0[0] * v0[0] + v0[1] * v0[1]) + (v0[2] * v0[2] + v0[3] * v0[3]) + (v1[0] * v1[0] + v1[1] * v1[1]) + (v1[2] * v1[2] + v1[3] * v1[3]);
                    u32x4 w; w.x = cvt_pk_bf16(v0[0], v0[1]); w.y = cvt_pk_bf16(v0[2], v0[3]); w.z = cvt_pk_bf16(v1[0], v1[1]); w.w = cvt_pk_bf16(v1[2], v1[3]);
                    *(u32x4*)(rowp + bj * HALF) = w; }
                s += __shfl_xor(s, 16); s += __shfl_xor(s, 32);
                if (fq == 0) ss[(size_t)row * SS_LD + u.pn * 4 + wc] = s; }
    }
};
struct EpiDaQkv { static constexpr bool PERM = true, AFTER_DRAIN = false; bf16_t* O; const float* rope;
    __device__ __forceinline__ void operator()(const f32x4 (&acc)[2][2][4][2], const Unit& u, int wr, int wc, int fr, int fq) const {
        const int row0 = u.pm * BM + wr * 64 + fr, col0 = u.pn * BM + wc * 32 + 8 * fq;
        const bool rp = (u.pn < 8) && (u.pm < 128);
#pragma unroll
        for (int ai = 0; ai < 2; ++ai)
#pragma unroll
            for (int m = 0; m < 4; ++m) { const int row = row0 + ai * HALF + m * 16; bf16_t* rowp = O + (size_t)row * 3072 + col0;
                if (rp) { const int t = row & 4095, pos = (wc & 1) ? (t & 63) : (t >> 6); const f32x4* rpp = (const f32x4*)(rope + (size_t)(pos * 16 + 4 * fq) * 2); const f32x4 c01 = rpp[0], c23 = rpp[1];
#pragma unroll
                    for (int bj = 0; bj < 2; ++bj) { const f32x4 v0 = acc[ai][bj][m][0], v1 = acc[ai][bj][m][1];
                        u32x4 w;
                        w.x = cvt_pk_bf16(v0[0] * c01[0] - v0[1] * c01[1], v0[0] * c01[1] + v0[1] * c01[0]);
                        w.y = cvt_pk_bf16(v0[2] * c01[2] - v0[3] * c01[3], v0[2] * c01[3] + v0[3] * c01[2]);
                        w.z = cvt_pk_bf16(v1[0] * c23[0] - v1[1] * c23[1], v1[0] * c23[1] + v1[1] * c23[0]);
                        w.w = cvt_pk_bf16(v1[2] * c23[2] - v1[3] * c23[3], v1[2] * c23[3] + v1[3] * c23[2]);
                        *(u32x4*)(rowp + bj * HALF) = w; } }
                else {
#pragma unroll
                    for (int bj = 0; bj < 2; ++bj) { const f32x4 v0 = acc[ai][bj][m][0], v1 = acc[ai][bj][m][1];
                        u32x4 w; w.x = cvt_pk_bf16(v0[0], v0[1]); w.y = cvt_pk_bf16(v0[2], v0[3]); w.z = cvt_pk_bf16(v1[0], v1[1]); w.w = cvt_pk_bf16(v1[2], v1[3]);
                        *(u32x4*)(rowp + bj * HALF) = w; } } }
    }
};
struct EpiGqaQkv { static constexpr bool PERM = true, AFTER_DRAIN = false; bf16_t* O; float* ss;
    __device__ __forceinline__ void operator()(const f32x4 (&acc)[2][2][4][2], const Unit& u, int wr, int wc, int fr, int fq) const {
        const int row0 = u.pm * BM + wr * 64 + fr, col0 = u.pn * BM + wc * 32 + 8 * fq;
#pragma unroll
        for (int ai = 0; ai < 2; ++ai)
#pragma unroll
            for (int m = 0; m < 4; ++m) { const int row = row0 + ai * HALF + m * 16; bf16_t* rowp = O + (size_t)row * 1536 + col0;
#pragma unroll
                for (int bj = 0; bj < 2; ++bj) { const f32x4 v0 = acc[ai][bj][m][0], v1 = acc[ai][bj][m][1];
                    float s = (v0[0] * v0[0] + v0[1] * v0[1]) + (v0[2] * v0[2] + v0[3] * v0[3]) + (v1[0] * v1[0] + v1[1] * v1[1]) + (v1[2] * v1[2] + v1[3] * v1[3]);
                    u32x4 w; w.x = cvt_pk_bf16(v0[0], v0[1]); w.y = cvt_pk_bf16(v0[2], v0[3]); w.z = cvt_pk_bf16(v1[0], v1[1]); w.w = cvt_pk_bf16(v1[2], v1[3]);
                    *(u32x4*)(rowp + bj * HALF) = w;
                    s += __shfl_xor(s, 16); s += __shfl_xor(s, 32);
                    const int head = 2 * u.pn + bj;
                    if (fq == 0 && head < 10) ss[(size_t)row * SS_LD + head * 4 + wc] = s; } }
    }
};
struct EpiHg { static constexpr bool PERM = true, AFTER_DRAIN = false; bf16_t* O; const float* lb;
    __device__ __forceinline__ void operator()(const f32x4 (&acc)[2][2][4][2], const Unit& u, int wr, int wc, int fr, int fq) const {
        const int row0 = u.pm * BM + wr * 64 + fr, col0 = u.pn * BM + wc * 32 + 8 * fq;
        const int sec = u.pn >> 2, ch0 = (u.pn & 3) * BM + wc * 32 + 8 * fq;
        f32x4 l0[2], l1[2];
#pragma unroll
        for (int bj = 0; bj < 2; ++bj) { l0[bj] = (f32x4){0.f, 0.f, 0.f, 0.f}; l1[bj] = l0[bj];
            if (sec == 1 || sec == 2) { const f32x4* lp = (const f32x4*)(lb + (sec - 1) * 1024 + ch0 + bj * HALF); l0[bj] = lp[0]; l1[bj] = lp[1]; } }
#pragma unroll
        for (int ai = 0; ai < 2; ++ai)
#pragma unroll
            for (int m = 0; m < 4; ++m) { const int row = row0 + ai * HALF + m * 16; bf16_t* rowp = O + (size_t)row * 5120 + col0;
#pragma unroll
                for (int bj = 0; bj < 2; ++bj) { f32x4 v0 = acc[ai][bj][m][0], v1 = acc[ai][bj][m][1];
                    if (sec == 0 || sec == 4) {
#pragma unroll
                        for (int e = 0; e < 4; ++e) { v0[e] = silu_f(v0[e]); v1[e] = silu_f(v1[e]); } }
                    else if (sec == 1 || sec == 2) {
#pragma unroll
                        for (int e = 0; e < 4; ++e) { v0[e] = (1.f - l0[bj][e]) * sigm_f(-v0[e]); v1[e] = (1.f - l1[bj][e]) * sigm_f(-v1[e]); } }
                    u32x4 w; w.x = cvt_pk_bf16(v0[0], v0[1]); w.y = cvt_pk_bf16(v0[2], v0[3]); w.z = cvt_pk_bf16(v1[0], v1[1]); w.w = cvt_pk_bf16(v1[2], v1[3]);
                    *(u32x4*)(rowp + bj * HALF) = w; } }
    }
};
struct EpiPart { static constexpr bool PERM = true, AFTER_DRAIN = false; bf16_t* Phi;
    __device__ __forceinline__ void operator()(const f32x4 (&acc)[2][2][4][2], const Unit& u, int wr, int wc, int fr, int fq) const {
        const int row0 = (u.pm - 128) * BM + wr * 64 + fr, col0 = u.pn * BM + wc * 32 + 8 * fq;
#pragma unroll
        for (int ai = 0; ai < 2; ++ai)
#pragma unroll
            for (int m = 0; m < 4; ++m) { bf16_t* rowp = Phi + (size_t)(row0 + ai * HALF + m * 16) * 1024 + col0;
#pragma unroll
                for (int bj = 0; bj < 2; ++bj) { const f32x4 v0 = acc[ai][bj][m][0], v1 = acc[ai][bj][m][1];
                    u32x4 w; w.x = cvt_pk_bf16(v0[0], v0[1]); w.y = cvt_pk_bf16(v0[2], v0[3]); w.z = cvt_pk_bf16(v1[0], v1[1]); w.w = cvt_pk_bf16(v1[2], v1[3]);
                    *(u32x4*)(rowp + bj * HALF) = w;
                    u32x4 l;
                    l.x = cvt_pk_bf16(v0[0] - __builtin_bit_cast(float, w.x << 16), v0[1] - __builtin_bit_cast(float, w.x & 0xffff0000u));
                    l.y = cvt_pk_bf16(v0[2] - __builtin_bit_cast(float, w.y << 16), v0[3] - __builtin_bit_cast(float, w.y & 0xffff0000u));
                    l.z = cvt_pk_bf16(v1[0] - __builtin_bit_cast(float, w.z << 16), v1[1] - __builtin_bit_cast(float, w.z & 0xffff0000u));
                    l.w = cvt_pk_bf16(v1[2] - __builtin_bit_cast(float, w.w << 16), v1[3] - __builtin_bit_cast(float, w.w & 0xffff0000u));
                    *(u32x4*)(rowp + (size_t)2048 * 1024 + bj * HALF) = l; } }
    }
};

template <class Epi, class Sched, bool ALIGN_EPI = false, bool SP2 = false>
__device__ __forceinline__ void gemm_phase(PG8_LAS unsigned char* lds, const Gemm g, const Sched& S, const Epi& E, int wave_s) {
    const int tid_l = my_tid(wave_s);
    const int tid = tid_l, wid = __builtin_amdgcn_readfirstlane(tid >> 6), lane = tid & 63, wr = wid >> 2, wc = wid & 3, fr = lane & 15, fq = lane >> 4;
    const int K = g.ld ? g.ld : g.K, nt = g.K / BK;
    unsigned voffA[2], voffB[2];
#pragma unroll
    for (int i = 0; i < 2; ++i) { int R, C; stage_rc(tid * 16 + i * 8192, R, C); const int Rb = Epi::PERM ? ((R & ~31) + perm32(R & 31)) : R;
        voffA[i] = (unsigned)(R * K + C) * 2u; voffB[i] = (unsigned)(Rb * K + C) * 2u; }
    const size_t kstep = (size_t)(BK * 2);
    const size_t hstep = (size_t)HALF * K * 2;
    const size_t tstep = 2 * hstep;
    const unsigned ldsw = (unsigned)wid * 1024u;
    const int aoff = lds_byte(wr * 64 + fr, fq * 8), boff = lds_byte(wc * 32 + fr, fq * 8);
#define PG8_SA(b, h) (((b) * 2 + (h)) * HTB)
#define PG8_SB(b, h) ((4 + (b) * 2 + (h)) * HTB)
#define PG8_STAGE(bufoff, gbase, voff) do { _Pragma("unroll") for (int _i = 0; _i < 2; ++_i) \
        __builtin_amdgcn_global_load_lds((const unsigned*)((const char*)(gbase) + (voff)[_i]), (PG8_LAS unsigned*)(lds + (bufoff) + ldsw + _i * 8192), 16, 0, 0); } while (0)
#define PG8_LDA(dst, b, h) do { _Pragma("unroll") for (int m = 0; m < 4; ++m) _Pragma("unroll") for (int k = 0; k < 2; ++k) dst[m][k] = *(const PG8_LAS bf16x8*)(lds + PG8_SA(b, h) + aoff + m * 2048 + k * 1024); } while (0)
#define PG8_LDB(dst, b, h) do { _Pragma("unroll") for (int n = 0; n < 2; ++n) _Pragma("unroll") for (int k = 0; k < 2; ++k) dst[n][k] = *(const PG8_LAS bf16x8*)(lds + PG8_SB(b, h) + boff + n * 2048 + k * 1024); } while (0)
#define PG8_MMA(ai, bj, At, Bt) do { __builtin_amdgcn_s_setprio(1); _Pragma("unroll") for (int m = 0; m < 4; ++m) _Pragma("unroll") for (int n = 0; n < 2; ++n) _Pragma("unroll") for (int k = 0; k < 2; ++k) \
        acc[ai][bj][m][n] = __builtin_amdgcn_mfma_f32_16x16x32_bf16(Bt[n][k], At[m][k], acc[ai][bj][m][n], 0, 0, 0); __builtin_amdgcn_s_setprio(0); } while (0)
#define PG8_WAIT_V(n) asm volatile("s_waitcnt vmcnt(" #n ")" ::: "memory")
#define PG8_WAIT_L(n) asm volatile("s_waitcnt lgkmcnt(" #n ")" ::: "memory")
#define PG8_BAR __builtin_amdgcn_s_barrier()
#define PG8_SCHED __builtin_amdgcn_sched_barrier(0)
    float z0 = 0.f; asm volatile("" : "+v"(z0)); const f32x4 zacc = (f32x4){z0, z0, z0, z0};
    Unit cur, nxt; int ui = 0;
    if (!S.next(0, cur)) return;
    f32x4 acc[2][2][4][2];
#pragma unroll
    for (int a = 0; a < 2; ++a)
#pragma unroll
        for (int b = 0; b < 2; ++b)
#pragma unroll
            for (int m = 0; m < 4; ++m)
#pragma unroll
                for (int n = 0; n < 2; ++n) acc[a][b][m][n] = zacc;
    bf16x8 At[4][2], B0[2][2], B1[2][2];
    const char* cA = (const char*)g.A + (size_t)cur.pm * tstep; const char* cB = (const char*)g.Bt + (size_t)cur.pn * tstep;
    S.a_ready(cur);
    if constexpr (SP2) {
        PG8_STAGE(PG8_SB(0, 0), cB, voffB); PG8_STAGE(PG8_SB(0, 1), cB + hstep, voffB); PG8_STAGE(PG8_SA(0, 0), cA, voffA); PG8_STAGE(PG8_SA(0, 1), cA + hstep, voffA);
        if (wr == 1) PG8_BAR;
        PG8_WAIT_V(2); PG8_BAR;
        PG8_STAGE(PG8_SB(1, 0), cB + kstep, voffB); PG8_STAGE(PG8_SA(1, 0), cA + kstep, voffA); PG8_STAGE(PG8_SB(1, 1), cB + hstep + kstep, voffB);
        PG8_WAIT_V(6); PG8_BAR;
    } else {
        PG8_STAGE(PG8_SB(0, 0), cB, voffB); PG8_STAGE(PG8_SA(0, 0), cA, voffA); PG8_STAGE(PG8_SB(0, 1), cB + hstep, voffB); PG8_STAGE(PG8_SA(0, 1), cA + hstep, voffA);
        if (wr == 1) PG8_BAR;
        PG8_WAIT_V(4); PG8_BAR;
        PG8_STAGE(PG8_SB(1, 0), cB + kstep, voffB); PG8_STAGE(PG8_SA(1, 0), cA + kstep, voffA); PG8_STAGE(PG8_SB(1, 1), cB + hstep + kstep, voffB);
        PG8_WAIT_V(6); PG8_BAR;
    }
    for (;;) {
        const bool has_next = S.next(ui + 1, nxt);
        const char* nA = has_next ? (const char*)g.A + (size_t)nxt.pm * tstep : cA; const char* nB = has_next ? (const char*)g.Bt + (size_t)nxt.pn * tstep : cB;
        for (int t = 0; t < nt; t += 2) {
            const bool last = (t == nt - 2);
            const char* a1 = cA + (size_t)(t + 1) * kstep;
            const char* a2 = last ? nA : cA + (size_t)(t + 2) * kstep; const char* b2 = last ? nB : cB + (size_t)(t + 2) * kstep;
            const char* a3 = a2 + kstep; const char* b3 = b2 + kstep;
            if (last && has_next) S.a_ready(nxt);
            if constexpr (SP2) {
            PG8_LDB(B0, 0, 0); PG8_LDB(B1, 0, 1); PG8_SCHED; PG8_LDA(At, 0, 0); PG8_STAGE(PG8_SA(1, 1), a1 + hstep, voffA);
            PG8_WAIT_V(8); PG8_WAIT_L(0); PG8_BAR; PG8_MMA(0, 0, At, B0); PG8_MMA(0, 1, At, B1); PG8_BAR; PG8_SCHED;
            PG8_LDA(At, 0, 1); PG8_STAGE(PG8_SB(0, 0), b2, voffB); PG8_STAGE(PG8_SB(0, 1), b2 + hstep, voffB); PG8_STAGE(PG8_SA(0, 0), a2, voffA);
            PG8_WAIT_V(8); PG8_WAIT_L(0); PG8_BAR; PG8_MMA(1, 0, At, B0); PG8_MMA(1, 1, At, B1); PG8_BAR; PG8_SCHED;
            PG8_LDB(B0, 1, 0); PG8_LDB(B1, 1, 1); PG8_SCHED; PG8_LDA(At, 1, 0); PG8_STAGE(PG8_SA(0, 1), a2 + hstep, voffA);
            PG8_WAIT_V(8); PG8_WAIT_L(0); PG8_BAR; PG8_MMA(0, 0, At, B0); PG8_MMA(0, 1, At, B1); PG8_BAR; PG8_SCHED;
            PG8_LDA(At, 1, 1); PG8_STAGE(PG8_SB(1, 0), b3, voffB); PG8_STAGE(PG8_SB(1, 1), b3 + hstep, voffB); PG8_STAGE(PG8_SA(1, 0), a3, voffA);
            PG8_WAIT_V(8); PG8_WAIT_L(0); PG8_BAR; PG8_MMA(1, 0, At, B0); PG8_MMA(1, 1, At, B1); PG8_BAR; PG8_SCHED;
            } else {
            PG8_LDB(B0, 0, 0); PG8_SCHED; PG8_LDA(At, 0, 0); PG8_STAGE(PG8_SA(1, 1), a1 + hstep, voffA);
            PG8_WAIT_L(8); PG8_BAR; PG8_WAIT_L(0); PG8_MMA(0, 0, At, B0); PG8_BAR; PG8_SCHED;
            PG8_LDB(B1, 0, 1); PG8_STAGE(PG8_SB(0, 0), b2, voffB);
            PG8_BAR; PG8_WAIT_L(0); PG8_MMA(0, 1, At, B1); PG8_BAR;
            PG8_LDA(At, 0, 1); PG8_STAGE(PG8_SA(0, 0), a2, voffA);
            PG8_BAR; PG8_WAIT_L(0); PG8_MMA(1, 0, At, B0); PG8_BAR; PG8_SCHED;
            PG8_STAGE(PG8_SB(0, 1), b2 + hstep, voffB);
            PG8_WAIT_V(6); PG8_BAR; PG8_MMA(1, 1, At, B1); PG8_BAR;
            PG8_LDB(B0, 1, 0); PG8_SCHED; PG8_LDA(At, 1, 0); PG8_STAGE(PG8_SA(0, 1), a2 + hstep, voffA);
            PG8_WAIT_L(8); PG8_BAR; PG8_WAIT_L(0); PG8_MMA(0, 0, At, B0); PG8_BAR; PG8_SCHED;
            PG8_LDB(B1, 1, 1); PG8_STAGE(PG8_SB(1, 0), b3, voffB);
            PG8_BAR; PG8_WAIT_L(0); PG8_MMA(0, 1, At, B1); PG8_BAR;
            PG8_LDA(At, 1, 1); PG8_STAGE(PG8_SA(1, 0), a3, voffA);
            PG8_BAR; PG8_WAIT_L(0); PG8_MMA(1, 0, At, B0); PG8_BAR; PG8_SCHED;
            PG8_STAGE(PG8_SB(1, 1), b3 + hstep, voffB);
            PG8_WAIT_V(6); PG8_BAR; PG8_MMA(1, 1, At, B1); PG8_BAR;
            }
        }
        if constexpr (ALIGN_EPI) { if (wr == 0) PG8_BAR; }
        if constexpr (!Epi::AFTER_DRAIN) { E(acc, cur, wr, wc, fr, fq); S.done(cur); }
        if (!has_next) break;
#pragma unroll
        for (int a = 0; a < 2; ++a)
#pragma unroll
            for (int b = 0; b < 2; ++b)
#pragma unroll
                for (int m = 0; m < 4; ++m)
#pragma unroll
                    for (int n = 0; n < 2; ++n) acc[a][b][m][n] = zacc;
        cur = nxt; cA = nA; cB = nB; ++ui;
        if constexpr (ALIGN_EPI) { if (wr == 1) PG8_BAR; }
    }
    PG8_WAIT_V(0);
    if constexpr (!ALIGN_EPI) { if (wr == 0) PG8_BAR; }
    PG8_BAR;
    if constexpr (Epi::AFTER_DRAIN) { E.fused(acc, cur, wr, wc, fr, fq, lds, wid, lane); S.done(cur); }
#undef PG8_SA
#undef PG8_SB
#undef PG8_STAGE
#undef PG8_LDA
#undef PG8_LDB
#undef PG8_MMA
#undef PG8_WAIT_V
#undef PG8_WAIT_L
#undef PG8_BAR
#undef PG8_SCHED
}
}
namespace att {
typedef unsigned short bf16;
using bf16x8 = __attribute__((ext_vector_type(8))) short;
using s16x4  = __attribute__((ext_vector_type(4))) short;
using f32x16 = __attribute__((ext_vector_type(16))) float;
using u32x4  = __attribute__((ext_vector_type(4))) unsigned;
constexpr int NW = 8, QBLK = 32, KVBLK = 64;
constexpr float THR = 8.f;
constexpr int SDEPTH = 2;
constexpr size_t SHM_V = KVBLK * 128 * 2, SHM_K = KVBLK * 128 * 2, SHM_ATTN = 3 * SHM_V + 2 * SHM_K + NW * 64 * 4;
#define KSWZ(row, colB) ((row) * 256 + ((colB) ^ (((row) & 7) << 4)))
#define SBAR() __builtin_amdgcn_sched_barrier(0)
__device__ __forceinline__ int crow(int r, int hi) { return (r & 3) + 8 * (r >> 2) + 4 * hi; }
__device__ __forceinline__ unsigned cvtpk(float lo, float hi) { unsigned r; asm volatile("v_cvt_pk_bf16_f32 %0, %1, %2" : "=v"(r) : "v"(lo), "v"(hi)); return r; }
__device__ __forceinline__ bf16x8 ld8(const bf16* p) { return *reinterpret_cast<const bf16x8*>(p); }

template <int DQK>
__device__ __forceinline__ void partialSM(f32x16& p0, f32x16& p1, float& m_reg, float& mn, float& alpha) {
  constexpr float SCALE = (DQK == 64) ? 0.125f : 0.088388347648318440f;
  constexpr float C = SCALE * 1.4426950408889634f;
  float pmax = p0[0];
#pragma unroll
  for (int r = 1; r < 16; ++r) pmax = fmaxf(pmax, p0[r]);
#pragma unroll
  for (int r = 0; r < 16; ++r) pmax = fmaxf(pmax, p1[r]);
  { auto rr = __builtin_amdgcn_permlane32_swap(__float_as_uint(pmax), __float_as_uint(pmax), false, false);
    pmax = fmaxf(__uint_as_float(rr[0]), __uint_as_float(rr[1])); }
  if (__builtin_expect(__all(pmax - m_reg <= THR / SCALE), 1)) { mn = m_reg; alpha = 1.f; }
  else { mn = fmaxf(m_reg, pmax); alpha = __builtin_amdgcn_exp2f((m_reg - mn) * C); m_reg = mn; }
  float mnC = -mn * C;
#pragma unroll
  for (int r = 0; r < 16; ++r) p0[r] = fmaf(p0[r], C, mnC);
#pragma unroll
  for (int r = 0; r < 16; ++r) p1[r] = fmaf(p1[r], C, mnC);
#pragma unroll
  for (int r = 0; r < 16; ++r) p0[r] = __builtin_amdgcn_exp2f(p0[r]);
}
__device__ __forceinline__ void finishSM(f32x16& p0, f32x16& p1, float alpha, float& l_reg, bf16x8& pa0, bf16x8& pa1, bf16x8& pa2, bf16x8& pa3) {
#pragma unroll
  for (int r = 0; r < 16; ++r) p1[r] = __builtin_amdgcn_exp2f(p1[r]);
  float ps = 0;
#pragma unroll
  for (int r = 0; r < 16; ++r) ps += p0[r];
#pragma unroll
  for (int r = 0; r < 16; ++r) ps += p1[r];
  { auto rr = __builtin_amdgcn_permlane32_swap(__float_as_uint(ps), __float_as_uint(ps), false, false);
    ps = __uint_as_float(rr[0]) + __uint_as_float(rr[1]); }
  l_reg = l_reg * alpha + ps;
#define PK4(P, BASE, OUT) do { unsigned a0 = cvtpk(P[BASE + 0], P[BASE + 1]), a1 = cvtpk(P[BASE + 2], P[BASE + 3]);   \
    unsigned b0 = cvtpk(P[BASE + 4], P[BASE + 5]), b1 = cvtpk(P[BASE + 6], P[BASE + 7]);                              \
    auto r0 = __builtin_amdgcn_permlane32_swap(a0, b0, false, false); auto r1 = __builtin_amdgcn_permlane32_swap(a1, b1, false, false); \
    u32x4 w = {r0[0], r1[0], r0[1], r1[1]}; OUT = *reinterpret_cast<bf16x8*>(&w); } while (0)
  PK4(p0, 0, pa0); PK4(p0, 8, pa1); PK4(p1, 0, pa2); PK4(p1, 8, pa3);
#undef PK4
}
template <int DQK>
__device__ __forceinline__ void qkt(f32x16& p0, f32x16& p1, const char* Ks, const bf16x8* qr, int r32, int hi, int kcolB) {
  p0 = f32x16{}; p1 = f32x16{};
#pragma unroll
  for (int d0 = 0; d0 < DQK / 16; ++d0) { int cb = kcolB + (d0 * 16 + hi * 8) * 2;
    bf16x8 b0 = *reinterpret_cast<const bf16x8*>(Ks + KSWZ(r32, cb));
    bf16x8 b1 = *reinterpret_cast<const bf16x8*>(Ks + KSWZ(32 + r32, cb));
    p0 = __builtin_amdgcn_mfma_f32_32x32x16_bf16(b0, qr[d0], p0, 0, 0, 0);
    p1 = __builtin_amdgcn_mfma_f32_32x32x16_bf16(b1, qr[d0], p1, 0, 0, 0); }
}
__device__ __forceinline__ int v_st(int k, int c) { const int kk = (k & ~0xC) | ((k & 4) << 1) | ((k & 8) >> 1); return ((kk >> 3) * 4 + (c >> 5)) * 512 + ((kk & 7) * 32 + (c & 31)) * 2; }
__device__ __forceinline__ int v_rd_base(int lane) { return ((lane & 3) << 3) | (((lane >> 2) & 3) << 6) | (((lane >> 4) & 1) << 5) | (((lane >> 5) & 1) << 8); }
constexpr int v_rd_off(int d0, int ks, int half) { return d0 * 512 + ks * 4096 + half * 2048; }
template <int OFF> __device__ __forceinline__ s16x4 tr_read(int vb) {
  s16x4 r; asm volatile("ds_read_b64_tr_b16 %0, %1 offset:%2" : "=&v"(r) : "v"(vb), "i"(OFF) : "memory"); return r;
}
template <int D0> __device__ __forceinline__ void pv_one(f32x16& od, int vb, bf16x8 pa0, bf16x8 pa1, bf16x8 pa2, bf16x8 pa3) {
  const s16x4 l0 = tr_read<v_rd_off(D0, 0, 0)>(vb), h0 = tr_read<v_rd_off(D0, 0, 1)>(vb), l1 = tr_read<v_rd_off(D0, 1, 0)>(vb), h1 = tr_read<v_rd_off(D0, 1, 1)>(vb);
  const s16x4 l2 = tr_read<v_rd_off(D0, 2, 0)>(vb), h2 = tr_read<v_rd_off(D0, 2, 1)>(vb), l3 = tr_read<v_rd_off(D0, 3, 0)>(vb), h3 = tr_read<v_rd_off(D0, 3, 1)>(vb);
  asm volatile("s_waitcnt lgkmcnt(0)" ::: "memory"); SBAR();
#define PK(L, H) (bf16x8){L[0], L[1], L[2], L[3], H[0], H[1], H[2], H[3]}
  od = __builtin_amdgcn_mfma_f32_32x32x16_bf16(pa0, PK(l0, h0), od, 0, 0, 0);
  od = __builtin_amdgcn_mfma_f32_32x32x16_bf16(pa1, PK(l1, h1), od, 0, 0, 0);
  od = __builtin_amdgcn_mfma_f32_32x32x16_bf16(pa2, PK(l2, h2), od, 0, 0, 0);
  od = __builtin_amdgcn_mfma_f32_32x32x16_bf16(pa3, PK(l3, h3), od, 0, 0, 0);
#undef PK
}
__device__ __forceinline__ void pv_d0(f32x16* o, int vb, bf16x8 pa0, bf16x8 pa1, bf16x8 pa2, bf16x8 pa3) {
  pv_one<0>(o[0], vb, pa0, pa1, pa2, pa3); pv_one<1>(o[1], vb, pa0, pa1, pa2, pa3); pv_one<2>(o[2], vb, pa0, pa1, pa2, pa3); pv_one<3>(o[3], vb, pa0, pa1, pa2, pa3);
}

template <int DQK, int LDQ, int LDK, int LDO, int MODE>
__device__ __forceinline__ void attn_unit(const bf16* __restrict__ Qb, const bf16* __restrict__ K1, const bf16* __restrict__ V1, int n1,
                                          const bf16* __restrict__ K2, const bf16* __restrict__ V2, int seq, int kcolB, bf16* __restrict__ Ob, char* lds, int wave_s,
                                          float* stash, float lam, float oml, const float* subln) {
  const int tid_l = my_tid(wave_s);
  const int tid = tid_l, wid = tid >> 6, lane = tid & 63, r32 = lane & 31, hi = lane >> 5;
  char* V_lds = lds; char* K_lds = lds + 3 * SHM_V;
  float* ws = (float*)(lds + 3 * SHM_V + 2 * SHM_K) + wid * 64; float* li_l = ws; float* al_l = ws + 32;
  float m_reg = -1e30f, l_reg = 0; f32x16 o[4] = {}; bf16x8 qr[DQK / 16];
  const bf16* Qw = Qb + (long)(wid * QBLK + r32) * LDQ + hi * 8;
#pragma unroll
  for (int d0 = 0; d0 < DQK / 16; ++d0) qr[d0] = ld8(Qw + d0 * 16);
  const int sr = tid >> 4, sc = (tid & 15) * 8, vst0 = v_st(sr, sc), vst1 = v_st(32 + sr, sc);
  const int vb0 = (int)(uintptr_t)V_lds + v_rd_base(lane);
  struct { bf16x8 vs0, vs1, ks0, ks1; } sr_[SDEPTH];
  const int kr = tid >> 3, kcb = kcolB + (tid & 7) * 16;
#define SLOAD(i, k0) do { const int _k0 = (k0); const bool _s1 = _k0 < n1; const int _kk = _s1 ? _k0 : _k0 - n1; const long _off = (long)(_kk + sr) * LDK + sc; \
    const bf16* _vp = (_s1 ? V1 : V2) + _off; sr_[i].vs0 = ld8(_vp); sr_[i].vs1 = ld8(_vp + 32 * LDK); \
    if constexpr (DQK == 64) { sr_[i].ks0 = ld8((_s1 ? K1 : K2) + (long)(_kk + kr) * LDK + (kcb >> 1)); } \
    else { const bf16* _kp = (_s1 ? K1 : K2) + _off; sr_[i].ks0 = ld8(_kp); sr_[i].ks1 = ld8(_kp + 32 * LDK); } } while (0)
#define SWRITE(b, vsl, i) do { *(bf16x8*)(V_lds + (vsl) * (int)SHM_V + vst0) = sr_[i].vs0;          \
    *(bf16x8*)(V_lds + (vsl) * (int)SHM_V + vst1) = sr_[i].vs1; int kc = sc * 2;               \
    if constexpr (DQK == 64) { *(bf16x8*)(K_lds + (b) * SHM_K + KSWZ(kr, kcb)) = sr_[i].ks0; } \
    else { *(bf16x8*)(K_lds + (b) * SHM_K + KSWZ(sr, kc)) = sr_[i].ks0;                       \
    *(bf16x8*)(K_lds + (b) * SHM_K + KSWZ(32 + sr, kc)) = sr_[i].ks1; } } while (0)
#define SWAIT() do { if constexpr (DQK == 64) asm volatile("s_waitcnt vmcnt(3)" ::: "memory"); else asm volatile("s_waitcnt vmcnt(4)" ::: "memory"); } while (0)
#define RESC(a) do { if (__any((a) < 1.f)) { if (hi == 0) al_l[r32] = (a); asm volatile("s_waitcnt lgkmcnt(0)" ::: "memory"); \
    _Pragma("unroll") for (int d = 0; d < 4; ++d) _Pragma("unroll") for (int r = 0; r < 16; ++r) o[d][r] *= al_l[crow(r, hi)]; } } while (0)
  f32x16 pA0, pA1, pB0, pB1; float mnA, mnB, alA, alB; bf16x8 pa0, pa1, pa2, pa3; const int NT = seq / KVBLK;
  constexpr int SE = 0, SO = SDEPTH - 1;
  __syncthreads();
  int vp = 0, vc = 1, vn = 2;
  SLOAD(SE, 0); asm volatile("s_waitcnt vmcnt(0)" ::: "memory"); SWRITE(0, 0, SE); __syncthreads();
  qkt<DQK>(pA0, pA1, K_lds, qr, r32, hi, kcolB); partialSM<DQK>(pA0, pA1, m_reg, mnA, alA);
  SLOAD(SO, KVBLK); if (2 < NT) SLOAD(SE, 2 * KVBLK);
  SWAIT(); SWRITE(1, 1, SO); __syncthreads();
  for (int j = 1; j + 1 < NT; j += 2) {
    SBAR(); qkt<DQK>(pB0, pB1, K_lds + SHM_K, qr, r32, hi, kcolB);
    finishSM(pA0, pA1, alA, l_reg, pa0, pa1, pa2, pa3); SBAR();
    SLOAD(SO, (j + SDEPTH) * KVBLK); SBAR();
    pv_d0(o, vb0 + vp * (int)SHM_V, pa0, pa1, pa2, pa3); partialSM<DQK>(pB0, pB1, m_reg, mnB, alB);
    SWAIT(); SWRITE(0, vn, SE);
    RESC(alB); __syncthreads();
    { const int t_ = vp; vp = vc; vc = vn; vn = t_; }
    SBAR(); qkt<DQK>(pA0, pA1, K_lds, qr, r32, hi, kcolB);
    finishSM(pB0, pB1, alB, l_reg, pa0, pa1, pa2, pa3); SBAR();
    if (j + 3 < NT) SLOAD(SE, (j + 1 + SDEPTH) * KVBLK); SBAR();
    pv_d0(o, vb0 + vp * (int)SHM_V, pa0, pa1, pa2, pa3); partialSM<DQK>(pA0, pA1, m_reg, mnA, alA);
    SWAIT(); SWRITE(1, vn, SO);
    RESC(alA); __syncthreads();
    { const int t_ = vp; vp = vc; vc = vn; vn = t_; }
  }
  SBAR(); qkt<DQK>(pB0, pB1, K_lds + SHM_K, qr, r32, hi, kcolB);
  finishSM(pA0, pA1, alA, l_reg, pa0, pa1, pa2, pa3); SBAR();
  pv_d0(o, vb0 + vp * (int)SHM_V, pa0, pa1, pa2, pa3); partialSM<DQK>(pB0, pB1, m_reg, mnB, alB);
  RESC(alB);
  finishSM(pB0, pB1, alB, l_reg, pa0, pa1, pa2, pa3); SBAR();
  pv_d0(o, vb0 + vc * (int)SHM_V, pa0, pa1, pa2, pa3);
  if (hi == 0) li_l[r32] = l_reg; asm volatile("s_waitcnt lgkmcnt(0)" ::: "memory");
  float rli[16];
#pragma unroll
  for (int r = 0; r < 16; ++r) rli[r] = __builtin_amdgcn_rcpf(li_l[crow(r, hi)]);
  bf16* Ow = Ob + (long)(wid * QBLK) * LDO;
  if constexpr (MODE == 0) {
#pragma unroll
  for (int r = 0; r < 16; ++r) { int orow = crow(r, hi);
#pragma unroll
    for (int d0 = 0; d0 < 4; ++d0) { const float x = o[d0][r] * rli[r]; Ow[(long)orow * LDO + d0 * 32 + r32] = (bf16)cvtpk(x, x); } }
  } else if constexpr (MODE == 1) {
#pragma unroll
  for (int d0 = 0; d0 < 4; ++d0)
#pragma unroll
    for (int r = 0; r < 16; ++r) stash[(d0 * 16 + r) * 512 + tid] = o[d0][r] * rli[r];
  asm volatile("s_waitcnt vmcnt(0)" ::: "memory");
  } else {
  float gn[4];
#pragma unroll
  for (int d0 = 0; d0 < 4; ++d0) gn[d0] = subln[d0 * 32 + r32] * oml;
#pragma unroll
  for (int r = 0; r < 16; ++r) { const int orow = crow(r, hi); float s = 0.f;
#pragma unroll
    for (int d0 = 0; d0 < 4; ++d0) { const float av = stash[(d0 * 16 + r) * 512 + tid] - lam * (o[d0][r] * rli[r]); o[d0][r] = av; s += av * av; }
    s += __shfl_xor(s, 1); s += __shfl_xor(s, 2); s += __shfl_xor(s, 4); s += __shfl_xor(s, 8); s += __shfl_xor(s, 16);
    const float rinv = 1.f / sqrtf(s * (1.f / 128.f) + 1e-6f);
#pragma unroll
    for (int d0 = 0; d0 < 4; ++d0) { const float x = o[d0][r] * rinv * gn[d0]; Ow[(long)orow * LDO + d0 * 32 + r32] = (bf16)cvtpk(x, x); } }
  }
#undef SLOAD
#undef SWRITE
#undef SWAIT
#undef RESC
}
template <int DQK, int LDQ, int LDK, int LDO>
__device__ __forceinline__ void attn_unit_2b(const bf16* __restrict__ Qb, const bf16* __restrict__ K1, const bf16* __restrict__ V1, int n1,
                                          const bf16* __restrict__ K2, const bf16* __restrict__ V2, int seq, int kcolB, bf16* __restrict__ Ob, char* lds, int wave_s) {
  const int tid_l = my_tid(wave_s);
  const int tid = tid_l, wid = tid >> 6, lane = tid & 63, r32 = lane & 31, hi = lane >> 5;
  char* V_lds = lds; char* K_lds = lds + 2 * SHM_V;
  float* ws = (float*)(lds + 2 * SHM_V + 2 * SHM_K) + wid * 64; float* li_l = ws; float* al_l = ws + 32;
  float m_reg = -1e30f, l_reg = 0; f32x16 o[4] = {}; bf16x8 qr[DQK / 16];
  const bf16* Qw = Qb + (long)(wid * QBLK + r32) * LDQ + hi * 8;
#pragma unroll
  for (int d0 = 0; d0 < DQK / 16; ++d0) qr[d0] = ld8(Qw + d0 * 16);
  const int sr = tid >> 4, sc = (tid & 15) * 8, vst0 = v_st(sr, sc), vst1 = v_st(32 + sr, sc);
  const int vb0 = (int)(uintptr_t)V_lds + v_rd_base(lane);
  struct { bf16x8 vs0, vs1, ks0, ks1; } sr_[SDEPTH];
  const int kr = tid >> 3, kcb = kcolB + (tid & 7) * 16;
#define SLOAD(i, k0) do { const int _k0 = (k0); const bool _s1 = _k0 < n1; const int _kk = _s1 ? _k0 : _k0 - n1; const long _off = (long)(_kk + sr) * LDK + sc; \
    const bf16* _vp = (_s1 ? V1 : V2) + _off; sr_[i].vs0 = ld8(_vp); sr_[i].vs1 = ld8(_vp + 32 * LDK); \
    if constexpr (DQK == 64) { sr_[i].ks0 = ld8((_s1 ? K1 : K2) + (long)(_kk + kr) * LDK + (kcb >> 1)); } \
    else { const bf16* _kp = (_s1 ? K1 : K2) + _off; sr_[i].ks0 = ld8(_kp); sr_[i].ks1 = ld8(_kp + 32 * LDK); } } while (0)
#define SWRITE(b, i) do { *(bf16x8*)(V_lds + (b) * SHM_V + vst0) = sr_[i].vs0;          \
    *(bf16x8*)(V_lds + (b) * SHM_V + vst1) = sr_[i].vs1; int kc = sc * 2;               \
    if constexpr (DQK == 64) { *(bf16x8*)(K_lds + (b) * SHM_K + KSWZ(kr, kcb)) = sr_[i].ks0; } \
    else { *(bf16x8*)(K_lds + (b) * SHM_K + KSWZ(sr, kc)) = sr_[i].ks0;                       \
    *(bf16x8*)(K_lds + (b) * SHM_K + KSWZ(32 + sr, kc)) = sr_[i].ks1; } } while (0)
#define SWAIT() do { if constexpr (DQK == 64) asm volatile("s_waitcnt vmcnt(3)" ::: "memory"); else asm volatile("s_waitcnt vmcnt(4)" ::: "memory"); } while (0)
#define RESC(a) do { if (__any((a) < 1.f)) { if (hi == 0) al_l[r32] = (a); asm volatile("s_waitcnt lgkmcnt(0)" ::: "memory"); \
    _Pragma("unroll") for (int d = 0; d < 4; ++d) _Pragma("unroll") for (int r = 0; r < 16; ++r) o[d][r] *= al_l[crow(r, hi)]; } } while (0)
  f32x16 pA0, pA1, pB0, pB1; float mnA, mnB, alA, alB; bf16x8 pa0, pa1, pa2, pa3; const int NT = seq / KVBLK;
  constexpr int SE = 0, SO = SDEPTH - 1;
  __syncthreads();
  SLOAD(SE, 0); asm volatile("s_waitcnt vmcnt(0)" ::: "memory"); SWRITE(0, SE); __syncthreads();
  qkt<DQK>(pA0, pA1, K_lds, qr, r32, hi, kcolB); partialSM<DQK>(pA0, pA1, m_reg, mnA, alA);
  SLOAD(SO, KVBLK); if (2 < NT) SLOAD(SE, 2 * KVBLK);
  SWAIT(); SWRITE(1, SO); __syncthreads();
  for (int j = 1; j + 1 < NT; j += 2) {
    SBAR(); qkt<DQK>(pB0, pB1, K_lds + SHM_K, qr, r32, hi, kcolB);
    finishSM(pA0, pA1, alA, l_reg, pa0, pa1, pa2, pa3); SBAR();
    SLOAD(SO, (j + SDEPTH) * KVBLK); SBAR();
    pv_d0(o, vb0, pa0, pa1, pa2, pa3); partialSM<DQK>(pB0, pB1, m_reg, mnB, alB);
    __syncthreads(); SWAIT(); SWRITE(0, SE);
    RESC(alB); __syncthreads();
    SBAR(); qkt<DQK>(pA0, pA1, K_lds, qr, r32, hi, kcolB);
    finishSM(pB0, pB1, alB, l_reg, pa0, pa1, pa2, pa3); SBAR();
    if (j + 3 < NT) SLOAD(SE, (j + 1 + SDEPTH) * KVBLK); SBAR();
    pv_d0(o, vb0 + (int)SHM_V, pa0, pa1, pa2, pa3); partialSM<DQK>(pA0, pA1, m_reg, mnA, alA);
    __syncthreads(); SWAIT(); SWRITE(1, SO);
    RESC(alA); __syncthreads();
  }
  SBAR(); qkt<DQK>(pB0, pB1, K_lds + SHM_K, qr, r32, hi, kcolB);
  finishSM(pA0, pA1, alA, l_reg, pa0, pa1, pa2, pa3); SBAR();
  pv_d0(o, vb0, pa0, pa1, pa2, pa3); partialSM<DQK>(pB0, pB1, m_reg, mnB, alB);
  __syncthreads(); RESC(alB);
  finishSM(pB0, pB1, alB, l_reg, pa0, pa1, pa2, pa3); SBAR();
  pv_d0(o, vb0 + (int)SHM_V, pa0, pa1, pa2, pa3);
  if (hi == 0) li_l[r32] = l_reg; asm volatile("s_waitcnt lgkmcnt(0)" ::: "memory");
  float rli[16];
#pragma unroll
  for (int r = 0; r < 16; ++r) rli[r] = __builtin_amdgcn_rcpf(li_l[crow(r, hi)]);
  bf16* Ow = Ob + (long)(wid * QBLK) * LDO;
#pragma unroll
  for (int r = 0; r < 16; ++r) { int orow = crow(r, hi);
#pragma unroll
    for (int d0 = 0; d0 < 4; ++d0) { const float x = o[d0][r] * rli[r]; Ow[(long)orow * LDO + d0 * 32 + r32] = (bf16)cvtpk(x, x); } }
#undef SLOAD
#undef SWRITE
#undef SWAIT
#undef RESC
}
}
constexpr int NLAT = 32768, NCTX = 2048, NTOK = NLAT + NCTX, DM = 1024, DFF = 2816;
constexpr float EPS = 1e-6f;
constexpr size_t MiB = 1u << 20;
constexpr size_t WS_MOD = 0;
constexpr size_t WS_LB = 1536 * 1024;
constexpr size_t WS_ROPE_DA = WS_LB + 8192;
constexpr size_t WS_ROPE_GQ = WS_ROPE_DA + 8192;
constexpr size_t WS_LAM = WS_ROPE_GQ + 16384;
constexpr size_t WS_SS = 2 * MiB;
constexpr size_t WS_XC = 8 * MiB;
constexpr size_t WS_W = 16 * MiB;
constexpr size_t W_FIN = 0, W_FOUT = W_FIN + (size_t)8 * 5632 * 1024, W_DAQ = W_FOUT + (size_t)8 * 1024 * 2816, W_DAO = W_DAQ + (size_t)2 * 3072 * 1024,
                 W_HGI = W_DAO + (size_t)2 * 1024 * 1024, W_HGO = W_HGI + (size_t)5120 * 1024, W_GQQ = W_HGO + (size_t)1024 * 1024, W_GQO = W_GQQ + (size_t)1536 * 1024,
                 W_END = W_GQO + (size_t)1024 * 1024;
static_assert(WS_W + W_END * 2 <= 184 * MiB, "weights");
constexpr size_t WS_H = 184 * MiB;
constexpr size_t WS_Y = 252 * MiB;
constexpr size_t WS_U = 320 * MiB;
constexpr size_t WS_END = WS_U + (size_t)NTOK * 5120 * 2;
constexpr int LDS_BYTES = 147456;
constexpr int NPHASE = 44;

typedef unsigned short bf16;
typedef float f32x4 __attribute__((ext_vector_type(4)));
typedef unsigned u32x4 __attribute__((ext_vector_type(4)));
typedef unsigned u32x2 __attribute__((ext_vector_type(2)));
typedef short bf16x8 __attribute__((ext_vector_type(8)));
#define LAS __attribute__((address_space(3)))

__device__ __forceinline__ unsigned f2bf(float f) { unsigned u = __builtin_bit_cast(unsigned, f); return (u + 0x7fffu + ((u >> 16) & 1u)) >> 16; }
typedef float f32x2_t __attribute__((ext_vector_type(2))); typedef __bf16 bf16x2_t __attribute__((ext_vector_type(2)));
__device__ __forceinline__ unsigned pk2(float lo, float hi) { const f32x2_t v = {lo, hi}; const bf16x2_t b = __builtin_convertvector(v, bf16x2_t); return __builtin_bit_cast(unsigned, b); }
__device__ __forceinline__ float bf_lo(unsigned w) { return __builtin_bit_cast(float, w << 16); }
__device__ __forceinline__ float bf_hi(unsigned w) { return __builtin_bit_cast(float, w & 0xffff0000u); }
typedef _Float16 h16x2 __attribute__((ext_vector_type(2)));
__device__ __forceinline__ unsigned pkh(float lo, float hi) { const h16x2 h = {(_Float16)lo, (_Float16)hi}; return __builtin_bit_cast(unsigned, h); }
__device__ __forceinline__ float h_lo(unsigned w) { return (float)__builtin_bit_cast(h16x2, w)[0]; }
__device__ __forceinline__ float h_hi(unsigned w) { return (float)__builtin_bit_cast(h16x2, w)[1]; }
__device__ __forceinline__ float wave_sum(float v) {
#pragma unroll
    for (int o = 1; o < 64; o <<= 1) v += __shfl_xor(v, o);
    return v;
}
__device__ __forceinline__ float sum8(float v) { v += __shfl_xor(v, 1); v += __shfl_xor(v, 2); v += __shfl_xor(v, 4); return v; }

struct Args { const float* in[21]; float* out; unsigned char* ws; int ph_lo, ph_hi; };

__device__ __forceinline__ void conv_item(const float* W, int K, int N, bf16* WT, int mode, float* scr, int item, int lane) {
    const int nblk = N / 32, kb = item / nblk, nb = item % nblk, k0 = 64 * kb, n0 = 32 * nb;
    int drow0 = n0;
    if (mode == 1) { const int up = n0 >= DFF, j0 = up ? n0 - DFF : n0; drow0 = (j0 >> 7) * 256 + (j0 & 127) + (up ? 128 : 0); }
    { f32x4 t[8]; const int kr8 = lane >> 3, n4 = (lane & 7) * 4;
#pragma unroll
      for (int i = 0; i < 8; ++i) t[i] = *(const f32x4*)(W + (size_t)(k0 + kr8 + 8 * i) * N + n0 + n4);
#pragma unroll
      for (int i = 0; i < 8; ++i) { float* d = scr + (kr8 + 8 * i) * 33 + n4; d[0] = t[i][0]; d[1] = t[i][1]; d[2] = t[i][2]; d[3] = t[i][3]; } }
    asm volatile("s_waitcnt vmcnt(0) lgkmcnt(0)" ::: "memory");
    const int c = lane & 7;
#pragma unroll
    for (int j = 0; j < 4; ++j) { const int n = (lane >> 3) + 8 * j; const float* s = scr + (8 * c) * 33 + n;
        u32x4 o; o.x = pk2(s[0 * 33], s[1 * 33]); o.y = pk2(s[2 * 33], s[3 * 33]); o.z = pk2(s[4 * 33], s[5 * 33]); o.w = pk2(s[6 * 33], s[7 * 33]);
        *(u32x4*)(WT + (size_t)(drow0 + n) * K + k0 + 8 * c) = o; }
    asm volatile("s_waitcnt lgkmcnt(0)" ::: "memory");
}

struct RowP {
    const void* src_lat; const void* src_ctx; void* dst_lat; void* dst_ctx; int rows; int src_f32, dst_f32;
    int apply; const bf16* Y; const float* ss; const float* g_post; const float* mod_a; int gate_idx; float weight;
    int next; const float* g_pre; const float* mod_n; int shift_idx; bf16* H;
};
__device__ __forceinline__ void row_proc(const float* mod_a, const float* mod_n, const float* g_post, const float* g_pre, void* dst_lat, void* dst_ctx, bf16* Hh, float weight, int gate_idx, int shift_idx, int apply, int next, int src_f32, int dst_f32,
                                         f32x4 (&ca)[4], f32x4 (&cb)[4], f32x4 (&cs)[4], int& cur_m, f32x4 (&v)[4], const u32x2 (&xw)[4], const u32x2 (&yw)[4], float sv, int row, int lane) {
    if (!src_f32) {
#pragma unroll
        for (int j = 0; j < 4; ++j) v[j] = (f32x4){h_lo(xw[j].x), h_hi(xw[j].x), h_lo(xw[j].y), h_hi(xw[j].y)}; }
    const bool lat = row < NLAT; const int mrow = lat ? (row >> 12) : 8;
    if (mrow != cur_m) { cur_m = mrow;
        const float* gate = mod_a + (size_t)mrow * 9216 + gate_idx * 1024; const float* shift = mod_n + (size_t)mrow * 9216 + shift_idx * 1024; const float* scale = shift + 1024;
#pragma unroll
        for (int j = 0; j < 4; ++j) { const int c4 = lane + 64 * j;
            if (apply) { const f32x4 gp = ((const f32x4*)g_post)[c4], gt = ((const f32x4*)gate)[c4]; ca[j] = gp * gt * weight; }
            if (next) { const f32x4 gq = ((const f32x4*)g_pre)[c4], sc = ((const f32x4*)scale)[c4]; cb[j] = gq * (sc + 1.f); cs[j] = ((const f32x4*)shift)[c4]; } } }
    if (apply) {
        const float s = wave_sum(sv);
        const float rinv = 1.f / sqrtf(s * (1.f / DM) + EPS);
        void* const db = lat ? dst_lat : dst_ctx; const size_t o_ = (size_t)(lat ? row : row - NLAT) * DM;
#pragma unroll
        for (int j = 0; j < 4; ++j) { const int c4 = lane + 64 * j;
            v[j][0] += rinv * ca[j][0] * bf_lo(yw[j].x); v[j][1] += rinv * ca[j][1] * bf_hi(yw[j].x);
            v[j][2] += rinv * ca[j][2] * bf_lo(yw[j].y); v[j][3] += rinv * ca[j][3] * bf_hi(yw[j].y);
            if (dst_f32) __builtin_nontemporal_store(v[j], (f32x4*)((float*)db + o_) + c4);
            else { u32x2 xo; xo.x = pkh(v[j][0], v[j][1]); xo.y = pkh(v[j][2], v[j][3]); __builtin_nontemporal_store(xo, (u32x2*)((bf16*)db + o_) + c4);
                   v[j] = (f32x4){h_lo(xo.x), h_hi(xo.x), h_lo(xo.y), h_hi(xo.y)}; } }
    }
    if (next) {
        float s2 = 0.f;
#pragma unroll
        for (int j = 0; j < 4; ++j) s2 += (v[j][0] * v[j][0] + v[j][1] * v[j][1]) + (v[j][2] * v[j][2] + v[j][3] * v[j][3]);
        const float r2 = 1.f / sqrtf(wave_sum(s2) * (1.f / DM) + EPS);
#pragma unroll
        for (int j = 0; j < 4; ++j) { const int c4 = lane + 64 * j;
            u32x2 o; o.x = pk2(v[j][0] * r2 * cb[j][0] + cs[j][0], v[j][1] * r2 * cb[j][1] + cs[j][1]);
            o.y = pk2(v[j][2] * r2 * cb[j][2] + cs[j][2], v[j][3] * r2 * cb[j][3] + cs[j][3]);
            ((u32x2*)(Hh + (size_t)row * DM))[c4] = o; }
    }
}
__device__ __forceinline__ void rowwise(const RowP& p, int rbeg, int rend, int gw, int NGW, int lane) {
    const int per = (rend - rbeg + NGW - 1) / NGW; int row = rbeg + gw * per; const int last = min(rend, row + per);
    if (row >= last) return;
    f32x4 vA[4], vB[4]; u32x2 xA[4], xB[4], xC[4], xD[4], yA[4], yB[4], yC[4], yD[4]; float sA = 0.f, sB = 0.f, sC = 0.f, sD = 0.f;
    const void* const srcL = p.src_lat; const void* const srcC = p.src_ctx; const int sf32 = p.src_f32, df32 = p.dst_f32; const bf16* const Yp = p.Y; const float* const ssp = p.ss; const int app = p.apply;
    const float* const l_ma = p.mod_a; const float* const l_mn = p.mod_n; const float* const l_gpo = p.g_post; const float* const l_gpr = p.g_pre; void* const l_dl = p.dst_lat; void* const l_dc = p.dst_ctx;
    bf16* const l_H = p.H; const float l_w = p.weight; const int l_gi = p.gate_idx, l_si = p.shift_idx, l_nx = p.next;
    f32x4 ca[4], cb[4], cs[4]; int cur_m = -1;
#define VLOAD(V, R) do { const int _r = (R); _Pragma("unroll") for (int j = 0; j < 4; ++j) V[j] = __builtin_nontemporal_load((const f32x4*)((const float*)(_r < NLAT ? srcL : srcC) + (size_t)(_r < NLAT ? _r : _r - NLAT) * DM) + lane + 64 * j); } while (0)
#define RLOAD(V, XW, YW, SV, R) do { const int _r = (R); const void* _sb; size_t _o; if (_r < NLAT) { _sb = srcL; _o = (size_t)_r * DM; } else { _sb = srcC; _o = (size_t)(_r - NLAT) * DM; } \
        if (!sf32) { _Pragma("unroll") for (int j = 0; j < 4; ++j) XW[j] = __builtin_nontemporal_load((const u32x2*)((const bf16*)_sb + _o) + lane + 64 * j); } \
        if (app) { _Pragma("unroll") for (int j = 0; j < 4; ++j) YW[j] = __builtin_nontemporal_load((const u32x2*)(Yp + (size_t)_r * DM) + lane + 64 * j); SV = lane < 16 ? ssp[(size_t)_r * 40 + lane] : 0.f; } } while (0)
    RLOAD(vA, xA, yA, sA, row); if (row + 1 < last) RLOAD(vB, xB, yB, sB, row + 1);
    for (;;) {
        if (row + 2 < last) RLOAD(vA, xC, yC, sC, row + 2);
        if (row + 3 < last) RLOAD(vB, xD, yD, sD, row + 3);
        if (sf32) { VLOAD(vA, row); if (row + 1 < last) VLOAD(vB, row + 1); }
        row_proc(l_ma, l_mn, l_gpo, l_gpr, l_dl, l_dc, l_H, l_w, l_gi, l_si, app, l_nx, sf32, df32, ca, cb, cs, cur_m, vA, xA, yA, sA, row, lane);
        if (row + 1 < last) row_proc(l_ma, l_mn, l_gpo, l_gpr, l_dl, l_dc, l_H, l_w, l_gi, l_si, app, l_nx, sf32, df32, ca, cb, cs, cur_m, vB, xB, yB, sB, row + 1, lane);
        row += 2; if (row >= last) break;
        sA = sC; sB = sD;
#pragma unroll
        for (int j = 0; j < 4; ++j) { xA[j] = xC[j]; yA[j] = yC[j]; xB[j] = xD[j]; yB[j] = yD[j]; }
    }
#undef RLOAD
#undef VLOAD
}

__device__ __forceinline__ void rowwise_ctx(const RowP& p, const bf16* PB, int rbeg, int rend, int gw, int NGW, int lane) {
    for (int row = rbeg + gw; row < rend; row += NGW) {
        const size_t o_ = (size_t)(row - NLAT) * DM;
        f32x4 v[4], y[4]; float s = 0.f;
#pragma unroll
        for (int j = 0; j < 4; ++j) { const int c4 = lane + 64 * j;
            if (p.src_f32) v[j] = ((const f32x4*)((const float*)p.src_ctx + o_))[c4];
            else { const u32x2 w = ((const u32x2*)((const bf16*)p.src_ctx + o_))[c4]; v[j] = (f32x4){h_lo(w.x), h_hi(w.x), h_lo(w.y), h_hi(w.y)}; }
            { f32x4 acc4 = (f32x4){0.f, 0.f, 0.f, 0.f};
#pragma unroll
              for (int q = 0; q < 4; ++q) { const u32x2 w = ((const u32x2*)(PB + (size_t)q * 2048 * 1024 + o_))[c4]; acc4 += (f32x4){bf_lo(w.x), bf_hi(w.x), bf_lo(w.y), bf_hi(w.y)}; }
              y[j] = acc4; }
            s += (y[j][0] * y[j][0] + y[j][1] * y[j][1]) + (y[j][2] * y[j][2] + y[j][3] * y[j][3]); }
        const float rinv = 1.f / sqrtf(wave_sum(s) * (1.f / DM) + EPS);
        const float* gate = p.mod_a + (size_t)8 * 9216 + p.gate_idx * 1024; const float* shift = p.mod_n + (size_t)8 * 9216 + p.shift_idx * 1024; const float* scale = shift + 1024;
        float s2 = 0.f;
#pragma unroll
        for (int j = 0; j < 4; ++j) { const int c4 = lane + 64 * j; const f32x4 gp = ((const f32x4*)p.g_post)[c4], gt = ((const f32x4*)gate)[c4];
            v[j] += y[j] * (gp * gt * (p.weight * rinv)); { u32x2 xo; xo.x = pkh(v[j][0], v[j][1]); xo.y = pkh(v[j][2], v[j][3]); ((u32x2*)((bf16*)p.dst_ctx + o_))[c4] = xo; v[j] = (f32x4){h_lo(xo.x), h_hi(xo.x), h_lo(xo.y), h_hi(xo.y)}; }
            s2 += (v[j][0] * v[j][0] + v[j][1] * v[j][1]) + (v[j][2] * v[j][2] + v[j][3] * v[j][3]); }
        if (p.next) { const float r2 = 1.f / sqrtf(wave_sum(s2) * (1.f / DM) + EPS);
#pragma unroll
            for (int j = 0; j < 4; ++j) { const int c4 = lane + 64 * j; const f32x4 gq = ((const f32x4*)p.g_pre)[c4], sc = ((const f32x4*)scale)[c4], sh = ((const f32x4*)shift)[c4];
                const f32x4 hv = v[j] * r2 * gq * (sc + 1.f) + sh;
                u32x2 o; o.x = pk2(hv[0], hv[1]); o.y = pk2(hv[2], hv[3]); ((u32x2*)(p.H + (size_t)row * DM))[c4] = o; } }
    }
}

__device__ __forceinline__ void ld16(const bf16* p, float* f) {
    const u32x4 a = ((const u32x4*)p)[0], b = ((const u32x4*)p)[1];
    f[0] = bf_lo(a.x); f[1] = bf_hi(a.x); f[2] = bf_lo(a.y); f[3] = bf_hi(a.y); f[4] = bf_lo(a.z); f[5] = bf_hi(a.z); f[6] = bf_lo(a.w); f[7] = bf_hi(a.w);
    f[8] = bf_lo(b.x); f[9] = bf_hi(b.x); f[10] = bf_lo(b.y); f[11] = bf_hi(b.y); f[12] = bf_lo(b.z); f[13] = bf_hi(b.z); f[14] = bf_lo(b.w); f[15] = bf_hi(b.w);
}
__device__ __forceinline__ void st16(bf16* p, const float* f) {
    u32x4 a, b; a.x = pk2(f[0], f[1]); a.y = pk2(f[2], f[3]); a.z = pk2(f[4], f[5]); a.w = pk2(f[6], f[7]);
    b.x = pk2(f[8], f[9]); b.y = pk2(f[10], f[11]); b.z = pk2(f[12], f[13]); b.w = pk2(f[14], f[15]);
    ((u32x4*)p)[0] = a; ((u32x4*)p)[1] = b;
}
__device__ __forceinline__ void da_finish(const bf16* OM, bf16* H, const float* subln, const float* lamp, int rows, int gw, int NGW, int lane) {
    const float lam = lamp[0], oml = lamp[1]; const int d0 = (lane & 7) * 16;
    float g[16];
#pragma unroll
    for (int e = 0; e < 16; ++e) g[e] = subln[d0 + e] * oml;
    for (int row = gw; row < rows; row += NGW) {
        const bf16* p1 = OM + (size_t)row * 2048 + (lane >> 3) * 256 + d0;
        float a[16], b[16]; ld16(p1, a); ld16(p1 + 128, b);
        float s = 0.f;
#pragma unroll
        for (int e = 0; e < 16; ++e) { a[e] = a[e] - lam * b[e]; s += a[e] * a[e]; }
        s = sum8(s); const float rinv = 1.f / sqrtf(s * (1.f / 128.f) + EPS);
#pragma unroll
        for (int e = 0; e < 16; ++e) a[e] = a[e] * rinv * g[e];
        st16(H + (size_t)row * DM + lane * 16, a);
    }
}
__device__ __forceinline__ void hg_finish(bf16* OFH, const bf16* OB, const bf16* P, const float* hgn, int rows, int gw, int NGW, int lane) {
    const int d0 = (lane & 7) * 16; float g[16];
#pragma unroll
    for (int e = 0; e < 16; ++e) g[e] = hgn[d0 + e];
    for (int row = gw; row < rows; row += NGW) {
        float a[16], b[16], gt[16]; ld16(OFH + (size_t)row * DM + lane * 16, a); ld16(OB + (size_t)row * DM + lane * 16, b); ld16(P + (size_t)row * 5120 + 4096 + lane * 16, gt);
        float s = 0.f;
#pragma unroll
        for (int e = 0; e < 16; ++e) { a[e] += b[e]; s += a[e] * a[e]; }
        s = sum8(s); const float rinv = 1.f / sqrtf(s * (1.f / 128.f) + EPS);
#pragma unroll
        for (int e = 0; e < 16; ++e) a[e] = a[e] * rinv * g[e] * gt[e];
        st16(OFH + (size_t)row * DM + lane * 16, a);
    }
}
__device__ __forceinline__ void gqa_fix(bf16* QKV, const float* ss, const float* qn, const float* kn, const float* rope, int rows, int gw, int NGW, int lane) {
    const int d0 = (lane & 7) * 16;
    for (int row = gw; row < rows; row += NGW) {
#pragma unroll
        for (int pass = 0; pass < 2; ++pass) {
            if (pass == 1 && lane >= 16) break;
            const int head = pass * 8 + (lane >> 3);
            bf16* p = QKV + (size_t)row * 1536 + pass * 1024 + lane * 16;
            float a[16]; ld16(p, a);
            const f32x4 s4 = *(const f32x4*)(ss + (size_t)row * 40 + head * 4);
            const float rinv = 1.f / sqrtf(((s4[0] + s4[1]) + (s4[2] + s4[3])) * (1.f / 128.f) + EPS);
            const float* gn = (pass ? kn : qn) + d0;
#pragma unroll
            for (int e = 0; e < 16; ++e) a[e] = a[e] * rinv * gn[e];
            if (row < NLAT) { const int t = row & 4095, hiF = (lane & 7) >= 4, pos = hiF ? (t & 63) : (t >> 6), f0 = (lane & 7) * 8 - (hiF ? 32 : 0);
                const float* rp = rope + (size_t)(pos * 32 + f0) * 2;
#pragma unroll
                for (int q = 0; q < 8; ++q) { const float cs = rp[2 * q], sn = rp[2 * q + 1], x1 = a[2 * q], x2 = a[2 * q + 1]; a[2 * q] = x1 * cs - x2 * sn; a[2 * q + 1] = x1 * sn + x2 * cs; } }
            st16(p, a);
        }
    }
}

__device__ __forceinline__ long hg_row(int ci, int t, int dir, int b) {
    if (ci < 4) { int p = ci * 64 + t; if (dir) p = 255 - p; return (long)NLAT + b * 256 + p; }
    int p = (ci - 4) * 64 + t; if (dir) p = 4095 - p; return (long)b * 4096 + p;
}
__device__ __forceinline__ void stf8(float* d, bf16x8 v) {
    const u32x4 w = __builtin_bit_cast(u32x4, v);
    ((f32x4*)d)[0] = (f32x4){bf_lo(w.x), bf_hi(w.x), bf_lo(w.y), bf_hi(w.y)}; ((f32x4*)d)[1] = (f32x4){bf_lo(w.z), bf_hi(w.z), bf_lo(w.w), bf_hi(w.w)};
}
typedef float f32x4s __attribute__((ext_vector_type(4)));
__device__ __forceinline__ unsigned short bfr(float x) { return (unsigned short)pk2(x, x); }
__device__ __forceinline__ void hg_scan(const bf16* P, bf16* OF, bf16* OB, unsigned char* lds, int G_, int bx, int tid) {
    constexpr int PW = 272, PN = 144;
    unsigned char* QG = lds; unsigned char* KG = QG + 64 * PW; unsigned char* QX = KG + 64 * PW; unsigned char* ST = QX + 64 * PW;
    unsigned char* KDT = ST + 64 * PW; unsigned char* VT = KDT + 128 * PN; unsigned char* ATT = VT + 64 * PN;
    float* SEG = (float*)(ATT + 64 * PN); float* EGL = SEG + 512;
    const int lane = tid & 63, w = tid >> 6, fr = lane & 15, fq = lane >> 4;
    const int c = tid & 127, g = tid >> 7;
    const int vs = tid >> 3, vcb = (tid & 7) * 8;
    const int tt = w >> 1, nb2 = (w & 1) * 2;
    float z0 = 0.f; asm volatile("" : "+v"(z0));
    const f32x4s zz4 = (f32x4s){z0, z0, z0, z0};
    for (int u = bx; u < 256; u += G_) {
        const int vh = u & 1, dir = (u >> 1) & 1, h = (u >> 2) & 7, b = u >> 5;
        bf16* Od = dir ? OB : OF;
        const long rstep = dir ? -5120 : 5120;
        f32x4s Sacc[4];
#pragma unroll
        for (int q = 0; q < 4; ++q) Sacc[q] = zz4;
        for (int idx = tid; idx < 64 * PW / 16; idx += 512) ((f32x4s*)ST)[idx] = zz4;
        unsigned rq[16], rk[16], nq[16], nk[16]; bf16x8 rv, nv;
#define HLOADC(Q, K, V, ci) do { const bf16* _p = P + hg_row(ci, 16 * g, dir, b) * 5120 + h * 128 + c; \
        _Pragma("unroll") for (int i = 0; i < 16; ++i) { Q[i] = _p[i * rstep]; K[i] = _p[i * rstep + 1024 + dir * 1024]; } \
        V = *(const bf16x8*)(P + hg_row(ci, vs, dir, b) * 5120 + 3072 + h * 128 + vh * 64 + vcb); } while (0)
        HLOADC(rq, rk, rv, 0);
        nv = rv;
#pragma unroll
        for (int i = 0; i < 16; ++i) { nq[i] = rq[i]; nk[i] = rk[i]; }
        for (int ci = 0; ci < 68; ++ci) {
            float lfp[16], kf[16], qf[16]; float run = 0.f;
#pragma unroll
            for (int i = 0; i < 16; ++i) { kf[i] = __builtin_bit_cast(float, rk[i] << 16); qf[i] = __builtin_bit_cast(float, rq[i] << 16);
                run += __logf(fmaxf(1.f - kf[i], 1e-30f)); lfp[i] = run; }
            SEG[g * 128 + c] = run;
#pragma unroll
            for (int e = 0; e < 8; ++e) *(unsigned short*)(VT + (vcb + e) * PN + vs * 2) = (unsigned short)rv[e];
            __syncthreads();
            if (ci + 1 < 68) HLOADC(nq, nk, nv, ci + 1);
            { const float s0 = SEG[c], s1 = SEG[128 + c], s2 = SEG[256 + c], s3 = SEG[384 + c];
              const float off = g == 0 ? 0.f : (g == 1 ? s0 : (g == 2 ? s0 + s1 : s0 + s1 + s2)), Gm = s0 + s1, Gl = (s0 + s1) + (s2 + s3);
              const float eGm = __expf(Gm), eLm = __expf(Gl - Gm);
              float kd[16];
#pragma unroll
              for (int i = 0; i < 16; ++i) { float d = off + lfp[i] - Gm; d = fminf(fmaxf(d, -80.f), 80.f);
                  const float e1 = __expf(d), e2 = __builtin_amdgcn_rcpf(e1);
                  const float qg = qf[i] * e1, kg = kf[i] * e2; kd[i] = kg * eLm;
                  const int o = (16 * g + i) * PW + 2 * c;
                  *(unsigned short*)(QG + o) = bfr(qg); *(unsigned short*)(KG + o) = bfr(kg); *(unsigned short*)(QX + o) = bfr(qg * eGm); }
              u32x4 k0, k1;
              k0.x = pk2(kd[0], kd[1]); k0.y = pk2(kd[2], kd[3]); k0.z = pk2(kd[4], kd[5]); k0.w = pk2(kd[6], kd[7]);
              k1.x = pk2(kd[8], kd[9]); k1.y = pk2(kd[10], kd[11]); k1.z = pk2(kd[12], kd[13]); k1.w = pk2(kd[14], kd[15]);
              *(u32x4*)(KDT + c * PN + 32 * g) = k0; *(u32x4*)(KDT + c * PN + 32 * g + 16) = k1;
              if (g == 0) EGL[c] = __expf(Gl); }
            __syncthreads();
            f32x4s oacc[2], aacc[2];
#pragma unroll
            for (int n = 0; n < 2; ++n) { oacc[n] = zz4; aacc[n] = zz4; }
#pragma unroll
            for (int kk = 0; kk < 4; ++kk) { const int ko = (32 * kk + 8 * fq) * 2;
                const bf16x8 a = *(const bf16x8*)(QG + (16 * tt + fr) * PW + ko), ax = *(const bf16x8*)(QX + (16 * tt + fr) * PW + ko);
#pragma unroll
                for (int n = 0; n < 2; ++n) { const bf16x8 bk = *(const bf16x8*)(KG + (16 * (nb2 + n) + fr) * PW + ko), bs = *(const bf16x8*)(ST + (16 * (nb2 + n) + fr) * PW + ko);
                    aacc[n] = __builtin_amdgcn_mfma_f32_16x16x32_bf16(a, bk, aacc[n], 0, 0, 0);
                    oacc[n] = __builtin_amdgcn_mfma_f32_16x16x32_bf16(ax, bs, oacc[n], 0, 0, 0); } }
#pragma unroll
            for (int n = 0; n < 2; ++n)
#pragma unroll
                for (int j = 0; j < 4; ++j) { const int t = 16 * tt + 4 * fq + j, s = 16 * (nb2 + n) + fr; const float val = (s <= t) ? aacc[n][j] : 0.f;
                    *(unsigned short*)(ATT + t * PN + s * 2) = bfr(val); }
            __syncthreads();
#pragma unroll
            for (int kk = 0; kk < 2; ++kk) { const int ko = (32 * kk + 8 * fq) * 2;
                const bf16x8 a = *(const bf16x8*)(ATT + (16 * tt + fr) * PN + ko);
#pragma unroll
                for (int n = 0; n < 2; ++n) { const bf16x8 bv = *(const bf16x8*)(VT + (16 * (nb2 + n) + fr) * PN + ko);
                    oacc[n] = __builtin_amdgcn_mfma_f32_16x16x32_bf16(a, bv, oacc[n], 0, 0, 0); } }
#pragma unroll
            for (int j = 0; j < 4; ++j) { const long r = hg_row(ci, 16 * tt + 4 * fq + j, dir, b);
#pragma unroll
                for (int n = 0; n < 2; ++n) Od[r * DM + h * 128 + vh * 64 + 16 * (nb2 + n) + fr] = bfr(oacc[n][j]); }
            { const f32x4s eg = *(const f32x4s*)(EGL + 16 * w + 4 * fq);
#pragma unroll
              for (int q = 0; q < 4; ++q) Sacc[q] = Sacc[q] * eg;
#pragma unroll
              for (int kk = 0; kk < 2; ++kk) { const int ko = (32 * kk + 8 * fq) * 2;
                  const bf16x8 a = *(const bf16x8*)(KDT + (16 * w + fr) * PN + ko);
#pragma unroll
                  for (int q = 0; q < 4; ++q) { const bf16x8 bv = *(const bf16x8*)(VT + (16 * q + fr) * PN + ko);
                      Sacc[q] = __builtin_amdgcn_mfma_f32_16x16x32_bf16(a, bv, Sacc[q], 0, 0, 0); } }
#pragma unroll
              for (int q = 0; q < 4; ++q) { u32x2 o2; o2.x = pk2(Sacc[q][0], Sacc[q][1]); o2.y = pk2(Sacc[q][2], Sacc[q][3]);
                  *(u32x2*)(ST + (16 * q + fr) * PW + (16 * w + 4 * fq) * 2) = o2; } }
            __syncthreads();
#pragma unroll
            for (int i = 0; i < 16; ++i) { rq[i] = nq[i]; rk[i] = nk[i]; }
            rv = nv;
        }
#undef HLOADC
    }
}

#define XB_TMO      128
#define XB_XCNT(j)  (256  + 64 * (j))
#define XB_XSUB(j)  (1280 + 64 * (j))
#define XB_XGEN(j)  (2304 + 64 * (j))
#define XB_TOP      3328
#define XB_TOPGEN   3392
#define XCD_BAR_WORDS 3456
#define XB_SPIN_CAP (1u << 18)

__device__ __forceinline__ unsigned xb_ld(unsigned* p)              { return __hip_atomic_load(p, __ATOMIC_RELAXED, __HIP_MEMORY_SCOPE_AGENT); }
__device__ __forceinline__ unsigned xb_add(unsigned* p, unsigned v) { return __hip_atomic_fetch_add(p, v, __ATOMIC_RELAXED, __HIP_MEMORY_SCOPE_AGENT); }
__device__ __forceinline__ unsigned xb_xcc_id() { return (unsigned)__builtin_amdgcn_s_getreg((3 << 11) | 20) & 0xFu; }
#define XB_SPIN(cond, bar) do { unsigned _sp = 0; while (cond) { __builtin_amdgcn_s_sleep(1); \
    if ((++_sp & 255u) == 0u) { if (xb_ld(&(bar)[XB_TMO])) break; if (_sp > XB_SPIN_CAP) { atomicAdd(&(bar)[XB_TMO], 1u); break; } } } } while (0)

struct XcdBarrier {
    unsigned* bar; unsigned x;
    volatile LAS unsigned* st;
};

__device__ __forceinline__ XcdBarrier xcd_barrier_post(unsigned* bar, volatile LAS unsigned* st, int tid) {
    XcdBarrier b; b.bar = bar; b.x = xb_xcc_id(); b.st = st;
    if (tid == 0) (void)xb_add(&bar[XB_XCNT(b.x)], 1u);
    return b;
}
__device__ __forceinline__ void xcd_barrier_complete(unsigned* bar, unsigned x, unsigned& nloc, unsigned& nx) {
    const unsigned G = gridDim.x * gridDim.y * gridDim.z;
    unsigned sum, cnt, mine, sp = 0u;
    for (;;) {
        sum = 0u; cnt = 0u; mine = 0u;
#pragma unroll
        for (unsigned j = 0; j < 16; ++j) { const unsigned c = xb_ld(&bar[XB_XCNT(j)]); sum += c; cnt += (c > 0u) ? 1u : 0u; mine = (j == x) ? c : mine; }
        if (sum == G) break;
        __builtin_amdgcn_s_sleep(1);
        if ((++sp & 255u) == 0u) { if (xb_ld(&bar[XB_TMO])) break; if (sp > XB_SPIN_CAP) { atomicAdd(&bar[XB_TMO], 1u); break; } }
    }
    nloc = mine > 0u ? mine : 1u; nx = cnt > 0u ? cnt : 1u;
}

__device__ __forceinline__ void xcd_barrier(const XcdBarrier& b, int tid) {
    asm volatile("s_waitcnt vmcnt(0)" ::: "memory");
    __syncthreads();
    if (tid == 0) {
        unsigned* bar = b.bar;
        __builtin_amdgcn_s_waitcnt(0);
        unsigned nloc = b.st[0], nx = b.st[1];
        if (nloc == 0u) { xcd_barrier_complete(bar, b.x, nloc, nx); b.st[0] = nloc; b.st[1] = nx; }
        const unsigned old = xb_add(&bar[XB_XSUB(b.x)], 1u);
        const unsigned gen = old / nloc;
        if (old + 1u == (gen + 1u) * nloc) {
            __builtin_amdgcn_fence(__ATOMIC_RELEASE, "agent");
            asm volatile("s_waitcnt vmcnt(0)" ::: "memory");
            const unsigned og = xb_add(&bar[XB_TOP], 1u);
            const unsigned tg = og / nx;
            if (og + 1u == (tg + 1u) * nx) xb_add(&bar[XB_TOPGEN], 1u);
            else XB_SPIN(xb_ld(&bar[XB_TOPGEN]) == tg, bar);
            __builtin_amdgcn_fence(__ATOMIC_ACQUIRE, "agent");
            xb_add(&bar[XB_XGEN(b.x)], 1u);
            asm volatile("s_waitcnt vmcnt(0)" ::: "memory");
        } else {
            XB_SPIN(xb_ld(&bar[XB_XGEN(b.x)]) == gen, bar);
            __builtin_amdgcn_fence(__ATOMIC_ACQUIRE, "agent");
            asm volatile("s_waitcnt vmcnt(0)" ::: "memory");
        }
    }
    __syncthreads();
}

struct OneUnit { int pm, pn;
    __device__ __forceinline__ bool next(int i, pg8::Unit& u) const { u.pm = pm; u.pn = pn; return i == 0; }
    __device__ __forceinline__ void a_ready(const pg8::Unit&) const {}
    __device__ __forceinline__ void done(const pg8::Unit&) const {}
};
__device__ __forceinline__ void panel_barrier(unsigned* cnt, unsigned n, int tid) {
    asm volatile("s_waitcnt vmcnt(0)" ::: "memory"); __syncthreads();
    if (tid == 0) {
        __builtin_amdgcn_fence(__ATOMIC_RELEASE, "agent"); asm volatile("s_waitcnt vmcnt(0)" ::: "memory");
        (void)xb_add(cnt, 1u);
        unsigned sp = 0u; while (xb_ld(cnt) < n) { __builtin_amdgcn_s_sleep(1); if (++sp > (1u << 20)) break; }
        __builtin_amdgcn_fence(__ATOMIC_ACQUIRE, "agent"); asm volatile("s_waitcnt vmcnt(0)" ::: "memory");
    }
    __syncthreads();
}
constexpr size_t WS_BAR = 1792 * 1024;
__global__ void __launch_bounds__(512, 2) mk_fwd(Args args) {
    extern __shared__ __attribute__((aligned(16))) unsigned char lds[];
    cg::grid_group grid = cg::this_grid();
    const int G = gridDim.x, bx = blockIdx.x, NGW = G * 8;
#define TID_INIT const int tid = my_tid(wave_s); const int lane = tid & 63, wave = __builtin_amdgcn_readfirstlane(tid >> 6), gw = bx * 8 + wave; (void)lane; (void)gw;
    typedef const __attribute__((address_space(4))) unsigned char* kptr_t;
#define KIN(i) (*(const float* const __attribute__((address_space(4)))*)(kp + 8 * (i)))
#define PH_PTRS kptr_t kp = (kptr_t)__builtin_amdgcn_kernarg_segment_ptr(); asm volatile("" : "+s"(kp)); \
    unsigned char* ws = *(unsigned char* const __attribute__((address_space(4)))*)(kp + 176); float* const outp = *(float* const __attribute__((address_space(4)))*)(kp + 168); (void)outp; \
    float* MOD = (float*)(ws + WS_MOD); float* LB = (float*)(ws + WS_LB); float* ROPE_DA = (float*)(ws + WS_ROPE_DA); float* ROPE_GQ = (float*)(ws + WS_ROPE_GQ); \
    float* LAM = (float*)(ws + WS_LAM); float* SS = (float*)(ws + WS_SS); float* XC = (float*)(ws + WS_XC); \
    bf16* WB = (bf16*)(ws + WS_W); bf16* H = (bf16*)(ws + WS_H); bf16* Y = (bf16*)(ws + WS_Y); bf16* U = (bf16*)(ws + WS_U); bf16* OM = U + (size_t)NTOK * 3072; const float* norm_g = KIN(6); \
    (void)MOD; (void)LB; (void)ROPE_DA; (void)ROPE_GQ; (void)LAM; (void)SS; (void)XC; (void)WB; (void)H; (void)Y; (void)U; (void)OM; (void)norm_g;
    PG8_LAS unsigned char* ring = (PG8_LAS unsigned char*)lds;
    const int lo = args.ph_lo, hi = args.ph_hi; int pc = 0;
#define PH_ON (pc >= lo && pc < hi)
    volatile LAS unsigned* bst = (volatile LAS unsigned*)(ring + 140288);
    const int wave_s = __builtin_amdgcn_readfirstlane((int)threadIdx.x >> 6);
    if ((int)threadIdx.x == 0) { bst[0] = 0u; bst[1] = 0u; }
    __syncthreads();
    XcdBarrier xbar; xbar.bar = (unsigned*)(args.ws + WS_BAR); xbar.x = 0; xbar.st = bst;
    if (hi - lo > 1) xbar = xcd_barrier_post((unsigned*)(args.ws + WS_BAR), bst, (int)threadIdx.x);
#define PH_END do { if (pc >= lo && pc + 1 < hi) xcd_barrier(xbar, my_tid(wave_s)); ++pc; } while (0)

    if (PH_ON) { PH_PTRS
        TID_INIT
        float* sc = (float*)lds; float* red = sc + 9 * 1024;
        for (int idx = tid; idx < 9 * 1024; idx += 512) { const int r = idx >> 10, k = idx & 1023; const float v = r < 8 ? KIN(1)[r * 1024 + k] : KIN(3)[k]; sc[idx] = v / (1.f + expf(-v)); }
        __syncthreads();
        for (int ch = bx; ch < 576; ch += G) { const int layer = ch / 144, n0 = (ch % 144) * 64, c4 = tid & 15, ks = tid >> 4;
            const float* wp = KIN(4) + ((size_t)layer * 1024 + ks * 32) * 9216 + n0 + 4 * c4; const float* sk = sc + ks * 32;
            f32x4 acc[9];
#pragma unroll
            for (int r = 0; r < 9; ++r) acc[r] = (f32x4){0.f, 0.f, 0.f, 0.f};
#pragma unroll 8
            for (int k = 0; k < 32; ++k) { const f32x4 wv = __builtin_nontemporal_load((const f32x4*)(wp + (size_t)k * 9216));
#pragma unroll
                for (int r = 0; r < 9; ++r) acc[r] += wv * sk[r * 1024 + k]; }
#pragma unroll
            for (int r = 0; r < 9; ++r) *(f32x4*)(red + (ks * 9 + r) * 64 + 4 * c4) = acc[r];
            __syncthreads();
            for (int o = tid; o < 576; o += 512) { const int r = o >> 6, cc = o & 63; float s = KIN(5)[layer * 9216 + n0 + cc];
#pragma unroll 8
                for (int k2 = 0; k2 < 32; ++k2) s += red[(k2 * 9 + r) * 64 + cc];
                MOD[(size_t)(layer * 9 + r) * 9216 + n0 + cc] = s; }
            __syncthreads();
        }
        if (bx == G - 1) {
            for (int idx = tid; idx < 2048; idx += 512) { const int dir = idx >> 10, ch = idx & 1023; const float* lp = KIN(14) + (size_t)dir * 4 * 1024 + ch;
                const float v0 = lp[0], v1 = lp[1024], v2 = lp[2048], v3 = lp[3072], m = fmaxf(fmaxf(v0, v1), fmaxf(v2, v3));
                const float e0 = expf(v0 - m), e1 = expf(v1 - m), e2 = expf(v2 - m), e3 = expf(v3 - m); LB[idx] = e1 / (e0 + e1 + e2 + e3); }
            for (int idx = tid; idx < 64 * 16; idx += 512) { const int pos = idx >> 4, f = idx & 15; const float inv = powf(10000.f, -(float)f / 16.f), ang = (float)pos * inv;
                ROPE_DA[2 * idx] = cosf(ang); ROPE_DA[2 * idx + 1] = sinf(ang); }
            for (int idx = tid; idx < 64 * 32; idx += 512) { const int pos = idx >> 5, f = idx & 31; const float inv = powf(10000.f, -(float)f / 32.f), ang = (float)pos * inv;
                ROPE_GQ[2 * idx] = cosf(ang); ROPE_GQ[2 * idx + 1] = sinf(ang); }
            if (tid < 2) { const float* lp = KIN(10) + tid * 256; float s1 = 0.f, s2 = 0.f;
                for (int d = 0; d < 64; ++d) { s1 += lp[d] * lp[64 + d]; s2 += lp[128 + d] * lp[192 + d]; }
                const float li = 0.8f - 0.6f * expf(-0.3f * (float)(3 * tid)); LAM[2 * tid] = expf(s1) - expf(s2) + li; LAM[2 * tid + 1] = 1.f - li; }
        }
        __syncthreads();
        float* scr = (float*)(lds + wave * 16384);
        constexpr int NITEMS = 42240;
#define CONV_DECODE(IT, SRC, DST, KK, NN, MODE, RR) do { int r = (IT); MODE = 0; \
            if (r < 22528) { const int m = r / 2816; r -= m * 2816; SRC = KIN(7) + (size_t)m * 1024 * 5632; DST = WB + W_FIN + (size_t)m * 5632 * 1024; KK = 1024; NN = 5632; MODE = 1; } \
            else if ((r -= 22528) < 11264) { const int m = r / 1408; r -= m * 1408; SRC = KIN(8) + (size_t)m * 2816 * 1024; DST = WB + W_FOUT + (size_t)m * 1024 * 2816; KK = 2816; NN = 1024; } \
            else if ((r -= 11264) < 3072) { const int m = r / 1536; r -= m * 1536; SRC = KIN(9) + (size_t)m * 1024 * 3072; DST = WB + W_DAQ + (size_t)m * 3072 * 1024; KK = 1024; NN = 3072; } \
            else if ((r -= 3072) < 1024) { const int m = r / 512; r -= m * 512; SRC = KIN(12) + (size_t)m * 1024 * 1024; DST = WB + W_DAO + (size_t)m * 1024 * 1024; KK = 1024; NN = 1024; } \
            else if ((r -= 1024) < 2560) { SRC = KIN(13); DST = WB + W_HGI; KK = 1024; NN = 5120; } \
            else if ((r -= 2560) < 512) { SRC = KIN(16); DST = WB + W_HGO; KK = 1024; NN = 1024; } \
            else if ((r -= 512) < 768) { SRC = KIN(17); DST = WB + W_GQQ; KK = 1024; NN = 1536; } \
            else { r -= 768; SRC = KIN(20); DST = WB + W_GQO; KK = 1024; NN = 1024; } RR = r; } while (0)
#define CONV_LOAD(T, SRC, NN, RR) do { const int nblk = (NN) / 32, kb = (RR) / nblk, nb = (RR) % nblk; \
            _Pragma("unroll") for (int i = 0; i < 8; ++i) T[i] = __builtin_nontemporal_load((const f32x4*)((SRC) + (size_t)(64 * kb + (lane >> 3) + 8 * i) * (NN) + 32 * nb + (lane & 7) * 4)); } while (0)
        { int it = gw; const float* src = nullptr; bf16* dst = nullptr; int K = 0, N = 0, mode = 0, rr = 0; f32x4 t[8], tn[8];
          if (it < NITEMS) { CONV_DECODE(it, src, dst, K, N, mode, rr); CONV_LOAD(t, src, N, rr); }
          while (it < NITEMS) {
            const int nit = it + NGW; const float* nsrc = nullptr; bf16* ndst = nullptr; int nK = 0, nN = 0, nmode = 0, nrr = 0;
            if (nit < NITEMS) { CONV_DECODE(nit, nsrc, ndst, nK, nN, nmode, nrr); CONV_LOAD(tn, nsrc, nN, nrr); }
            { const int nblk = N / 32, kb = rr / nblk, nb = rr % nblk, k0 = 64 * kb, n0 = 32 * nb; int drow0 = n0;
              if (mode == 1) { const int up = n0 >= DFF, j0 = up ? n0 - DFF : n0; drow0 = (j0 >> 7) * 256 + (j0 & 127) + (up ? 128 : 0); }
              const int kr8 = lane >> 3, n4 = (lane & 7) * 4;
#pragma unroll
              for (int i = 0; i < 8; ++i) { float* d = scr + (kr8 + 8 * i) * 33 + n4; d[0] = t[i][0]; d[1] = t[i][1]; d[2] = t[i][2]; d[3] = t[i][3]; }
              asm volatile("s_waitcnt lgkmcnt(0)" ::: "memory");
              const int c = lane & 7;
#pragma unroll
              for (int j = 0; j < 4; ++j) { const int n = (lane >> 3) + 8 * j; const float* s = scr + (8 * c) * 33 + n;
                  u32x4 o; o.x = pk2(s[0 * 33], s[1 * 33]); o.y = pk2(s[2 * 33], s[3 * 33]); o.z = pk2(s[4 * 33], s[5 * 33]); o.w = pk2(s[6 * 33], s[7 * 33]);
                  __builtin_nontemporal_store(o, (u32x4*)(dst + (size_t)(drow0 + n) * K + k0 + 8 * c)); }
              asm volatile("s_waitcnt lgkmcnt(0)" ::: "memory"); }
            it = nit; src = nsrc; dst = ndst; K = nK; N = nN; mode = nmode; rr = nrr;
#pragma unroll
            for (int i = 0; i < 8; ++i) t[i] = tn[i];
          } }
#undef CONV_DECODE
#undef CONV_LOAD
    }
    if (lo == 0 && hi > 1) grid.sync();
    ++pc;

    size_t AoutO = 0, WoutO = 0; int Kout = 0;
    for (int t = 0; t <= 12; ++t) {
        const int i = t / 3, sub = t - 3 * i, kind = i % 3, jl = i / 3;
        const int rows = (t >= 11) ? NLAT : NTOK;
        if (PH_ON) { PH_PTRS
            RowP p;
            const bool first = (t <= 1);
            bf16* XT = U + (size_t)200 * 1024 * 1024 / 2;
            p.src_f32 = first; p.dst_f32 = (t == 12);
            p.src_lat = first ? (const void*)KIN(0) : (t == 12 ? (const void*)XT : (const void*)outp); p.src_ctx = first ? (const void*)KIN(2) : (const void*)XC;
            p.dst_lat = (t == 11) ? (void*)XT : (void*)outp; p.dst_ctx = XC; p.rows = rows;
            p.apply = t > 0; p.Y = Y; p.ss = SS;
            { const int tp = t > 0 ? t - 1 : 0, ip = tp / 3, sp = tp - 3 * ip; p.g_post = norm_g + (size_t)(ip * 6 + 2 * sp + 1) * 1024; p.mod_a = MOD + (size_t)ip * 9 * 9216; p.gate_idx = 3 * sp + 2; p.weight = sp == 1 ? 1.f : 0.5f; }
            p.next = t < 12; { const int ii = t < 12 ? i : 3, s2 = t < 12 ? sub : 2; p.g_pre = norm_g + (size_t)(ii * 6 + 2 * s2) * 1024; p.mod_n = MOD + (size_t)ii * 9 * 9216; p.shift_idx = 3 * s2; }
            p.H = H;
            const int nb = (t >= 1 && t <= 10) ? 64 : 0;
            bf16* PP = U + (size_t)200 * 1024 * 1024 / 2;
            if (bx < nb) {
                const int tile = bx >> 1, half = bx & 1, Kh = Kout >> 1;
                pg8::Gemm g{(const bf16*)(ws + AoutO) + half * Kh, (const bf16*)(ws + WoutO) + half * Kh, NTOK, 1024, Kh, Kout}; OneUnit S1{128 + (tile >> 2), tile & 3};
                pg8::EpiPart E{PP + (size_t)half * 2 * 2048 * 1024};
                pg8::gemm_phase<pg8::EpiPart, OneUnit, true, true>(ring, g, S1, E, wave_s);
                panel_barrier((unsigned*)(ws + WS_BAR + 16384) + ((t - 1) * 8 + (bx >> 3)) * 64, 8u, my_tid(wave_s));
                TID_INIT
                const int r0 = NLAT + 256 * (bx >> 3) + 32 * (bx & 7);
                rowwise_ctx(p, PP, r0, r0 + 32, wave, 8, lane);
            } else {
                TID_INIT
                rowwise(p, 0, nb ? NLAT : rows, (bx - nb) * 8 + wave, (G - nb) * 8, lane);
            }
        }
        PH_END;
        if (t == 12) break;
        const int mrows = (i == 3) ? NLAT : NTOK;

        if (sub != 1) {
            const int fidx = i * 2 + (sub >> 1);
            if (PH_ON) { PH_PTRS
                pg8::Gemm g{H, WB + W_FIN + (size_t)fidx * 5632 * 1024, rows, 5632, 1024}; pg8::StaticOrder S; S.init(rows, 5632, G, bx);
                pg8::EpiSwiglu E{U, DFF};
                pg8::gemm_phase<pg8::EpiSwiglu, pg8::StaticOrder, true, true>(ring, g, S, E, wave_s);
            }
            PH_END;
            AoutO = WS_U; WoutO = WS_W + 2 * (W_FOUT + (size_t)fidx * 1024 * 2816); Kout = DFF;
        } else if (kind == 0) {
            const bool need_ctx = i < 3;
            if (PH_ON) { PH_PTRS
                pg8::Gemm g{H, WB + W_DAQ + (size_t)jl * 3072 * 1024, NTOK, 3072, 1024}; pg8::StaticOrder S; S.init(NTOK, 3072, G, bx);
                pg8::EpiDaQkv E{U, ROPE_DA};
                pg8::gemm_phase<pg8::EpiDaQkv, pg8::StaticOrder, true, true>(ring, g, S, E, wave_s);
            }
            PH_END;
            if (PH_ON) { PH_PTRS
                const int nlat = 1024, ntot = nlat + (need_ctx ? 64 : 0);
                float* stash = (float*)OM + (size_t)bx * 32768;
                const float lam = LAM[2 * jl], oml = LAM[2 * jl + 1]; const float* subln = KIN(11) + jl * 128;
                for (int it = 0;; ++it) { const int u = it * G + bx; if (u >= ntot) break;
                    const bf16 *q0, *k1, *v1, *k2, *v2; bf16* ob; int n1, seq;
                    if (u < nlat) { int pair, qb; if (G == 256) { pair = it * 16 + (bx & 7) * 2 + (bx >> 7); qb = (bx >> 3) & 15; } else { pair = u >> 4; qb = u & 15; }
                        const int b = pair >> 3, h = pair & 7;
                        const bf16* base = U + (size_t)(b * 4096) * 3072 + h * 128; const bf16* cb = U + (size_t)(NLAT + b * 256) * 3072 + h * 128;
                        q0 = base + (size_t)(qb * 256) * 3072; k1 = base + 1024; v1 = base + 2048; k2 = cb + 1024; v2 = cb + 2048; n1 = 4096; seq = 4352;
                        ob = H + (size_t)(b * 4096 + qb * 256) * 1024 + h * 128;
                    } else { const int v = u - nlat, b = v >> 3, h = v & 7;
                        const bf16* cb = U + (size_t)(NLAT + b * 256) * 3072 + h * 128;
                        q0 = cb; k1 = cb + 1024; v1 = cb + 2048; k2 = k1; v2 = v1; n1 = 0; seq = 256;
                        ob = H + (size_t)(NLAT + b * 256) * 1024 + h * 128; }
                    att::attn_unit<64, 3072, 3072, 1024, 1>(q0, k1, v1, n1, k2, v2, seq, 0, ob, (char*)lds, wave_s, stash, lam, oml, subln);
                    att::attn_unit<64, 3072, 3072, 1024, 2>(q0 + 64, k1, v1, n1, k2, v2, seq, 128, ob, (char*)lds, wave_s, stash, lam, oml, subln);
                }
                __syncthreads();
            }
            PH_END;
            AoutO = WS_H; WoutO = WS_W + 2 * (W_DAO + (size_t)jl * 1024 * 1024); Kout = 1024;
        } else if (kind == 1) {
            if (PH_ON) { PH_PTRS
                pg8::Gemm g{H, WB + W_HGI, NTOK, 5120, 1024}; pg8::StaticOrder S; S.init(NTOK, 5120, G, bx);
                pg8::EpiHg E{U, LB};
                pg8::gemm_phase<pg8::EpiHg, pg8::StaticOrder, true, true>(ring, g, S, E, wave_s);
            }
            PH_END;
            if (PH_ON) { PH_PTRS TID_INIT hg_scan(U, H, Y, lds, G, bx, tid); }
            PH_END;
            if (PH_ON) { PH_PTRS TID_INIT hg_finish(H, Y, U, KIN(15) + jl * 128, mrows, gw, NGW, lane); }
            PH_END;
            AoutO = WS_H; WoutO = WS_W + 2 * W_HGO; Kout = 1024;
        } else {
            const bool need_ctx = i < 3;
            if (PH_ON) { PH_PTRS
                pg8::Gemm g{H, WB + W_GQQ, NTOK, 1536, 1024}; pg8::StaticOrder S; S.init(NTOK, 1536, G, bx);
                pg8::EpiGqaQkv E{U, SS};
                pg8::gemm_phase<pg8::EpiGqaQkv, pg8::StaticOrder, true, true>(ring, g, S, E, wave_s);
            }
            PH_END;
            if (PH_ON) { PH_PTRS TID_INIT gqa_fix(U, SS, KIN(18) + jl * 128, KIN(19) + jl * 128, ROPE_GQ, NTOK, gw, NGW, lane); }
            PH_END;
            if (PH_ON) { PH_PTRS
                const int nlat = 1024, ntot = nlat + (need_ctx ? 64 : 0);
                for (int it = 0;; ++it) { const int u = it * G + bx; if (u >= ntot) break;
                    if (u < nlat) { int pair, sb; if (G == 256) { pair = (it >> 1) * 8 + (bx & 7); sb = (it & 1) * 32 + (bx >> 3); } else { pair = u >> 6; sb = u & 63; }
                        const int b = pair >> 1, kvh = pair & 1, head = kvh * 4 + (sb >> 4), qb = sb & 15;
                        const bf16* base = U + (size_t)(b * 4096) * 1536; const bf16* cb = U + (size_t)(NLAT + b * 256) * 1536;
                        att::attn_unit_2b<128, 1536, 1536, 1024>(base + (size_t)(qb * 256) * 1536 + head * 128, base + 1024 + kvh * 128, base + 1280 + kvh * 128, 4096,
                                                              cb + 1024 + kvh * 128, cb + 1280 + kvh * 128, 4352, 0, H + (size_t)(b * 4096 + qb * 256) * 1024 + head * 128, (char*)lds, wave_s);
                    } else { const int v = u - nlat, b = v >> 3, head = v & 7, kvh = head >> 2;
                        const bf16* cb = U + (size_t)(NLAT + b * 256) * 1536;
                        att::attn_unit_2b<128, 1536, 1536, 1024>(cb + head * 128, cb + 1024 + kvh * 128, cb + 1280 + kvh * 128, 0, cb + 1024 + kvh * 128, cb + 1280 + kvh * 128, 256, 0,
                                                              H + (size_t)(NLAT + b * 256) * 1024 + head * 128, (char*)lds, wave_s); }
                }
                __syncthreads();
            }
            PH_END;
            AoutO = WS_H; WoutO = WS_W + 2 * W_GQO; Kout = 1024;
        }
        if (PH_ON) { PH_PTRS
            pg8::Gemm g{(const bf16*)(ws + AoutO), (const bf16*)(ws + WoutO), NLAT, 1024, Kout}; pg8::StaticOrder S; S.init(NLAT, 1024, G, bx);
            pg8::EpiY E{Y, SS};
            pg8::gemm_phase<pg8::EpiY, pg8::StaticOrder, true, true>(ring, g, S, E, wave_s);
        }
        PH_END;
    }
}

extern "C" void kernel_launch(void* const* d_in, const int* in_sizes, int n_in, void* d_out, int out_size, void* d_ws, size_t ws_size, hipStream_t stream) {
    static int grid = 0, mode = 0;
    if (grid == 0) {
        if (n_in != 21 || out_size != NLAT * DM || ws_size < WS_END) { fprintf(stderr, "kernel_launch: bad shapes n_in %d out %d ws %zu (need %zu)\n", n_in, out_size, ws_size, (size_t)WS_END); grid = -1; return; }
        int dev = 0, cus = 0, per_cu = 0;
        hipGetDevice(&dev); hipDeviceGetAttribute(&cus, hipDeviceAttributeMultiprocessorCount, dev);
        if (hipFuncSetAttribute((const void*)mk_fwd, hipFuncAttributeMaxDynamicSharedMemorySize, LDS_BYTES) != hipSuccess) { fprintf(stderr, "kernel_launch: hipFuncSetAttribute failed\n"); grid = -1; return; }
        if (hipOccupancyMaxActiveBlocksPerMultiprocessor(&per_cu, (const void*)mk_fwd, 512, LDS_BYTES) != hipSuccess || per_cu < 1) { fprintf(stderr, "kernel_launch: occupancy query says %d\n", per_cu); per_cu = 1; }
        (void)hipGetLastError();
        grid = cus * 1; mode = 1;
    }
    if (grid < 0) return;
    if (hipMemsetAsync((char*)d_ws + WS_BAR, 0, 65536, stream) != hipSuccess) { fprintf(stderr, "kernel_launch: memset failed\n"); return; }
    Args a{};
    for (int i = 0; i < 21; ++i) a.in[i] = (const float*)d_in[i];
    a.out = (float*)d_out; a.ws = (unsigned char*)d_ws;
    if (mode == 1) {
        a.ph_lo = 0; a.ph_hi = NPHASE;
        void* kargs[] = {&a};
        hipError_t e = hipLaunchCooperativeKernel((const void*)mk_fwd, dim3(grid), dim3(512), kargs, LDS_BYTES, stream);
        if (e == hipSuccess) return;
        fprintf(stderr, "kernel_launch: cooperative launch failed: %s (grid %d); falling back to one launch per phase\n", hipGetErrorString(e), grid);
        (void)hipGetLastError(); mode = 2;
    }
    for (int p = 0; p < NPHASE; ++p) { a.ph_lo = p; a.ph_hi = p + 1; hipLaunchKernelGGL(mk_fwd, dim3(grid), dim3(512), LDS_BYTES, stream, a); }
}
```
